# Optimizing an MI355X kernel written in HIP

```python
import math
import jax, jax.numpy as jnp
from jax import lax
import numpy as np

D_MODEL = 1024
BATCH = 8
SEQ = 4096
DEPTH = 2

MEM_LEN = 256
Q_BLOCK = 128
EPS = 1e-6
NEG = -1e30
FFN_RESIDUAL = 0.5
D_FF = 2816

SB_HEADS = 8
SB_HEAD_DIM = 64
SB_WIDTH = SB_HEADS * SB_HEAD_DIM

MLA_HEADS = 8
MLA_Q_RANK = 384
MLA_KV_RANK = 128
MLA_NOPE_DIM = 64
MLA_ROPE_DIM = 32
MLA_V_DIM = 64
MLA_WIDTH = MLA_HEADS * MLA_V_DIM
ROPE_THETA = 10000.0

DIL_GROUPS = ((128, 1), (512, 4), (2048, 16))
DIL_HEADS = 8
DIL_HEAD_DIM = 64
DIL_WIDTH = DIL_HEADS * DIL_HEAD_DIM

REL_BUCKETS = 32
REL_MAX_DIST = 2048

X_HEADS = 4
X_HEAD_DIM = 128
X_WIDTH = X_HEADS * X_HEAD_DIM

N_BRANCH = 3
IN_SPLITS = ([SB_WIDTH] * 3
             + [MLA_Q_RANK, MLA_KV_RANK, MLA_ROPE_DIM]
             + [DIL_WIDTH] * (3 * len(DIL_GROUPS))
             + [D_MODEL] * N_BRANCH)
N_IN = sum(IN_SPLITS)
IN_OFFSETS = [int(o) for o in np.cumsum(IN_SPLITS)[:-1]]

kernel_name = "hybrid_gated_sb_mla_dilated_macaron"


def rms_norm(x, g):
    xf = x.astype(jnp.float32)
    y = xf * lax.rsqrt(jnp.mean(xf * xf, axis=-1, keepdims=True) + EPS)
    return (y * g.astype(jnp.float32)).astype(x.dtype)


def swiglu(x, w_gate, w_up, w_down):
    return (jax.nn.silu(x @ w_gate) * (x @ w_up)) @ w_down


def rope(x, pos):
    half = x.shape[-1] // 2
    freqs = ROPE_THETA ** (-jnp.arange(half, dtype=jnp.float32) / half)
    ang = pos.astype(jnp.float32)[:, None] * freqs[None, :]
    cos = jnp.cos(ang)[:, None, :]
    sin = jnp.sin(ang)[:, None, :]
    x1, x2 = x[..., :half], x[..., half:]
    return jnp.concatenate([x1 * cos - x2 * sin, x1 * sin + x2 * cos], axis=-1).astype(x.dtype)


def to_blocks(t):
    b, s = t.shape[:2]
    return t.reshape(b, s // Q_BLOCK, Q_BLOCK, *t.shape[2:]).swapaxes(0, 1)


def from_blocks(t):
    t = t.swapaxes(0, 1)
    return t.reshape(t.shape[0], t.shape[1] * t.shape[2], *t.shape[3:])


def stick_breaking_attention(q, k, v):
    s = q.shape[1]
    scale = q.shape[-1] ** -0.5
    key_pos = jnp.arange(s)

    def block(args):
        qb, q0 = args
        z = jnp.einsum('bqhd,bkhd->bhqk', qb, k).astype(jnp.float32) * scale
        strict = key_pos[None, :] < (q0 + jnp.arange(Q_BLOCK))[:, None]
        log_beta = jax.nn.log_sigmoid(z)
        log_keep = jnp.where(strict, jax.nn.log_sigmoid(-z), 0.0)
        after = lax.cumsum(log_keep, axis=3, reverse=True) - log_keep
        w = jnp.where(strict, jnp.exp(log_beta + after), 0.0)
        return jnp.einsum('bhqk,bkhd->bqhd', w.astype(v.dtype), v)

    starts = jnp.arange(s // Q_BLOCK, dtype=jnp.int32) * Q_BLOCK
    return from_blocks(lax.map(block, (to_blocks(q), starts)))


def causal_softmax_attention(q, k, v, scale):
    s = q.shape[1]
    key_pos = jnp.arange(s)

    def block(args):
        qb, q0 = args
        logits = jnp.einsum('bqhd,bkhd->bhqk', qb, k).astype(jnp.float32) * scale
        causal = key_pos[None, :] <= (q0 + jnp.arange(Q_BLOCK))[:, None]
        p = jax.nn.softmax(jnp.where(causal, logits, NEG), axis=-1)
        return jnp.einsum('bhqk,bkhd->bqhd', p.astype(v.dtype), v)

    starts = jnp.arange(s // Q_BLOCK, dtype=jnp.int32) * Q_BLOCK
    return from_blocks(lax.map(block, (to_blocks(q), starts)))


def rel_bucket(dist):
    exact = REL_BUCKETS // 2
    d = jnp.maximum(dist, exact).astype(jnp.float32)
    large = exact + (jnp.log(d / exact) / math.log(REL_MAX_DIST / exact)
                     * (REL_BUCKETS - exact)).astype(jnp.int32)
    return jnp.where(dist < exact, dist, jnp.minimum(large, REL_BUCKETS - 1))


def dilated_group_attention(q, k, v, dilation, taps, bias_table):
    b, s, h, d = q.shape
    r = dilation
    L = s // r
    nb = -(-L // Q_BLOCK)
    Lp = nb * Q_BLOCK

    def residue_major(t):
        return t.reshape(b, L, r, h, d).swapaxes(1, 2)

    def pad(t, front):
        return jnp.pad(t, ((0, 0), (0, 0), (front, Lp - L), (0, 0), (0, 0)))

    qr = pad(residue_major(q), 0).reshape(b, r, nb, Q_BLOCK, h, d)
    kr = pad(residue_major(k), Q_BLOCK).reshape(b, r, nb + 1, Q_BLOCK, h, d)
    vr = pad(residue_major(v), Q_BLOCK).reshape(b, r, nb + 1, Q_BLOCK, h, d)
    kb = jnp.concatenate([kr[:, :, :-1], kr[:, :, 1:]], axis=3)
    vb = jnp.concatenate([vr[:, :, :-1], vr[:, :, 1:]], axis=3)

    logits = jnp.einsum('brnqhd,brnkhd->brnhqk', qr, kb).astype(jnp.float32) * d ** -0.5
    qi = jnp.arange(Q_BLOCK)
    kj = jnp.arange(2 * Q_BLOCK)
    steps = (qi[:, None] + Q_BLOCK) - kj[None, :]
    in_window = (steps >= 0) & (steps <= taps)
    key_idx = jnp.arange(nb)[:, None, None] * Q_BLOCK + kj[None, None, :] - Q_BLOCK
    valid = in_window[None] & (key_idx >= 0)
    bias = bias_table[rel_bucket(jnp.clip(steps, 0, taps) * r)]
    logits = logits + jnp.transpose(bias, (2, 0, 1)).astype(jnp.float32)
    logits = jnp.where(valid[None, None, :, None], logits, NEG)

    lse = jax.nn.logsumexp(logits, axis=-1)
    p = jnp.exp(logits - lse[..., None])
    out = jnp.einsum('brnhqk,brnkhd->brnqhd', p.astype(v.dtype), vb)
    out = out.reshape(b, r, Lp, h, d)[:, :, :L].swapaxes(1, 2).reshape(b, s, h, d)
    lse = jnp.transpose(lse, (0, 1, 2, 4, 3)).reshape(b, r, Lp, h)[:, :, :L]
    lse = lse.swapaxes(1, 2).reshape(b, s, h)
    return out, lse


def parallel_mixer(u, w_in, gate_bias, mla_q_norm, mla_w_uq, mla_kv_norm, mla_w_ukv,
                   w_branch_a, w_branch_b, w_branch_c, w_mix_out, rel_bias):
    b, s, _ = u.shape
    parts = jnp.split(u @ w_in, IN_OFFSETS, axis=-1)
    sb_q, sb_k, sb_v, c_q, c_kv, k_rope = parts[:6]
    dil = parts[6:6 + 3 * len(DIL_GROUPS)]
    g_a, g_b, g_c = parts[6 + 3 * len(DIL_GROUPS):]

    def heads(t, n):
        return t.reshape(b, s, n, -1)

    o_a = stick_breaking_attention(heads(sb_q, SB_HEADS), heads(sb_k, SB_HEADS),
                                   heads(sb_v, SB_HEADS)).reshape(b, s, SB_WIDTH)

    pos = jnp.arange(s)
    q = (rms_norm(c_q, mla_q_norm) @ mla_w_uq).reshape(b, s, MLA_HEADS, MLA_NOPE_DIM + MLA_ROPE_DIM)
    q = jnp.concatenate([q[..., :MLA_NOPE_DIM], rope(q[..., MLA_NOPE_DIM:], pos)], axis=-1)
    kv = (rms_norm(c_kv, mla_kv_norm) @ mla_w_ukv).reshape(b, s, MLA_HEADS, MLA_NOPE_DIM + MLA_V_DIM)
    k_pe = rope(k_rope[:, :, None, :], pos)
    k = jnp.concatenate([kv[..., :MLA_NOPE_DIM],
                         jnp.broadcast_to(k_pe, (b, s, MLA_HEADS, MLA_ROPE_DIM))], axis=-1)
    v = kv[..., MLA_NOPE_DIM:]
    o_b = causal_softmax_attention(q, k, v, (MLA_NOPE_DIM + MLA_ROPE_DIM) ** -0.5)
    o_b = o_b.reshape(b, s, MLA_WIDTH)

    outs, lses = [], []
    for g, (window, dilation) in enumerate(DIL_GROUPS):
        qg, kg, vg = (heads(t, DIL_HEADS) for t in dil[3 * g:3 * g + 3])
        o, lse = dilated_group_attention(qg, kg, vg, dilation, window // dilation,
                                         rel_bias[:, g * DIL_HEADS:(g + 1) * DIL_HEADS])
        outs.append(o)
        lses.append(lse)
    outs = jnp.stack(outs)
    alpha = jax.nn.softmax(jnp.stack(lses), axis=0)
    o_c = jnp.einsum('gbsh,gbshd->bshd', alpha.astype(outs.dtype), outs).reshape(b, s, DIL_WIDTH)

    merged = (jax.nn.sigmoid(g_a + gate_bias[0]) * (o_a @ w_branch_a)
              + jax.nn.sigmoid(g_b + gate_bias[1]) * (o_b @ w_branch_b)
              + jax.nn.sigmoid(g_c + gate_bias[2]) * (o_c @ w_branch_c))
    return merged @ w_mix_out


def memory_cross_attention(h, mem, w_q, w_kv, w_o):
    b, s, _ = h.shape
    m = mem.shape[1]
    q = (h @ w_q).reshape(b, s, X_HEADS, X_HEAD_DIM)
    kv = (mem @ w_kv).reshape(b, m, 2, X_HEADS, X_HEAD_DIM)
    k, v = kv[:, :, 0], kv[:, :, 1]
    logits = jnp.einsum('bshd,bmhd->bhsm', q, k).astype(jnp.float32) * X_HEAD_DIM ** -0.5
    p = jax.nn.softmax(logits, axis=-1)
    o = jnp.einsum('bhsm,bmhd->bshd', p.astype(v.dtype), v)
    return o.reshape(b, s, X_WIDTH) @ w_o


def setup_inputs(seed: int = 0) -> dict:
    key = jax.random.key(seed)
    ks = iter(jax.random.split(key, 32))

    def dense(shape, fan_in):
        return jax.random.normal(next(ks), shape, jnp.float32) * fan_in ** -0.5

    def gain(shape):
        return 1.0 + 0.02 * jax.random.normal(next(ks), shape, jnp.float32)

    Ld = DEPTH
    return {
        "x": jax.random.normal(next(ks), (BATCH, SEQ, D_MODEL), jnp.float32),
        "mem": jax.random.normal(next(ks), (BATCH, MEM_LEN, D_MODEL), jnp.float32),
        "ffn1_norm": gain((Ld, D_MODEL)),
        "ffn1_w_gate": dense((Ld, D_MODEL, D_FF), D_MODEL),
        "ffn1_w_up": dense((Ld, D_MODEL, D_FF), D_MODEL),
        "ffn1_w_down": dense((Ld, D_FF, D_MODEL), D_FF),
        "mix_norm": gain((Ld, D_MODEL)),
        "w_in": dense((Ld, D_MODEL, N_IN), D_MODEL),
        "gate_bias": 0.1 * jax.random.normal(next(ks), (Ld, N_BRANCH, D_MODEL), jnp.float32),
        "mla_q_norm": gain((Ld, MLA_Q_RANK)),
        "mla_w_uq": dense((Ld, MLA_Q_RANK, MLA_HEADS * (MLA_NOPE_DIM + MLA_ROPE_DIM)), MLA_Q_RANK),
        "mla_kv_norm": gain((Ld, MLA_KV_RANK)),
        "mla_w_ukv": dense((Ld, MLA_KV_RANK, MLA_HEADS * (MLA_NOPE_DIM + MLA_V_DIM)), MLA_KV_RANK),
        "w_branch_a": dense((Ld, SB_WIDTH, D_MODEL), SB_WIDTH),
        "w_branch_b": dense((Ld, MLA_WIDTH, D_MODEL), MLA_WIDTH),
        "w_branch_c": dense((Ld, DIL_WIDTH, D_MODEL), DIL_WIDTH),
        "w_mix_out": dense((Ld, D_MODEL, D_MODEL), D_MODEL),
        "rel_bias": 0.5 * jax.random.normal(next(ks), (REL_BUCKETS, DIL_HEADS * len(DIL_GROUPS)), jnp.float32),
        "xattn_norm": gain((Ld, D_MODEL)),
        "mem_norm": gain((Ld, D_MODEL)),
        "xattn_w_q": dense((Ld, D_MODEL, X_WIDTH), D_MODEL),
        "xattn_w_kv": dense((Ld, D_MODEL, 2 * X_WIDTH), D_MODEL),
        "xattn_w_o": dense((Ld, X_WIDTH, D_MODEL), X_WIDTH),
        "ffn2_norm": gain((Ld, D_MODEL)),
        "ffn2_w_gate": dense((Ld, D_MODEL, D_FF), D_MODEL),
        "ffn2_w_up": dense((Ld, D_MODEL, D_FF), D_MODEL),
        "ffn2_w_down": dense((Ld, D_FF, D_MODEL), D_FF),
        "final_norm": gain((D_MODEL,)),
    }


def reference(x, mem, ffn1_norm, ffn1_w_gate, ffn1_w_up, ffn1_w_down, mix_norm, w_in, gate_bias,
              mla_q_norm, mla_w_uq, mla_kv_norm, mla_w_ukv, w_branch_a, w_branch_b, w_branch_c,
              w_mix_out, rel_bias, xattn_norm, mem_norm, xattn_w_q, xattn_w_kv, xattn_w_o,
              ffn2_norm, ffn2_w_gate, ffn2_w_up, ffn2_w_down, final_norm):
    h = x
    for l in range(DEPTH):
        h = h + FFN_RESIDUAL * swiglu(rms_norm(h, ffn1_norm[l]),
                                      ffn1_w_gate[l], ffn1_w_up[l], ffn1_w_down[l])
        h = h + parallel_mixer(rms_norm(h, mix_norm[l]), w_in[l], gate_bias[l],
                               mla_q_norm[l], mla_w_uq[l], mla_kv_norm[l], mla_w_ukv[l],
                               w_branch_a[l], w_branch_b[l], w_branch_c[l], w_mix_out[l], rel_bias)
        h = h + memory_cross_attention(rms_norm(h, xattn_norm[l]), rms_norm(mem, mem_norm[l]),
                                       xattn_w_q[l], xattn_w_kv[l], xattn_w_o[l])
        h = h + FFN_RESIDUAL * swiglu(rms_norm(h, ffn2_norm[l]),
                                      ffn2_w_gate[l], ffn2_w_up[l], ffn2_w_down[l])
    return rms_norm(h, final_norm)
```

```cpp
#include <hip/hip_runtime.h>
#include <hip/hip_cooperative_groups.h>
#include <cstdio>
#include <cstdint>
namespace cg = cooperative_groups;

#ifndef MK_REP_SYNC
#define MK_REP_SYNC 1
#endif
#ifndef MK_REP_ATT
#define MK_REP_ATT 1
#endif
#ifndef MK_REP_GEMM
#define MK_REP_GEMM 1
#endif
#ifndef MK_MINPH
#define MK_MINPH 0
#endif
#ifndef MK_MAXPH
#define MK_MAXPH 50
#endif
#ifndef MK_PER_PHASE
#define MK_PER_PHASE 0
#endif

#define LAS __attribute__((address_space(3)))
#define DI __device__ __forceinline__
typedef unsigned short bf16_t;
typedef short bf16x8 __attribute__((ext_vector_type(8)));
typedef short s16x4 __attribute__((ext_vector_type(4)));
typedef float f32x4 __attribute__((ext_vector_type(4)));
typedef float f32x16 __attribute__((ext_vector_type(16)));
typedef unsigned u32x4 __attribute__((ext_vector_type(4)));
typedef unsigned u32x2 __attribute__((ext_vector_type(2)));
typedef float f32x2_t __attribute__((ext_vector_type(2)));
typedef __bf16 bf16x2_t __attribute__((ext_vector_type(2)));

DI unsigned pk2(float lo, float hi) { f32x2_t v = {lo, hi}; bf16x2_t b = __builtin_convertvector(v, bf16x2_t); return __builtin_bit_cast(unsigned, b); }
DI float bflo(unsigned u) { return __uint_as_float(u << 16); }
DI float bfhi(unsigned u) { return __uint_as_float(u & 0xffff0000u); }
DI float ex2(float x) { return __builtin_amdgcn_exp2f(x); }
DI float lg2(float x) { return __builtin_amdgcn_logf(x); }
DI float sigmoidf_(float x) { return __builtin_amdgcn_rcpf(1.0f + __builtin_amdgcn_exp2f(x * -1.4426950408889634f)); }
DI float max3f(float a, float b, float c) { float r; asm("v_max3_f32 %0, %1, %2, %3" : "=v"(r) : "v"(a), "v"(b), "v"(c)); return r; }
DI int ltid() { int t = threadIdx.x; asm volatile("" : "+v"(t)); return t; }

constexpr int T = 32768, DM = 1024, SEQ = 4096, NB = 8, FF = 2816, MEML = 256;
constexpr int TC = 8192, NCH = 4, BPC = 2;
constexpr int NINP = 9984;
constexpr int C_SBQ = 0, C_SBK = 512, C_SBV = 1024, C_CQ = 1536, C_CKV = 1920, C_KR = 2048, C_DIL = 2304, C_GATE = 6912;
constexpr float EPS = 1e-6f, LOG2E = 1.4426950408889634f;

constexpr size_t al(size_t x) { return (x + 255) & ~(size_t)255; }
constexpr size_t WS_CTR = 0;
constexpr size_t WS_BAR = 1024;
constexpr size_t WS_SSZ = 16384;
constexpr int    NSSZ = 12;
constexpr size_t WS_SS0 = WS_SSZ + (size_t)NSSZ * T * 4;
constexpr size_t WS_SSM = WS_SS0 + (size_t)T * 4;
constexpr size_t WS_ROPE = WS_SSM + 2048 * 4;
constexpr size_t WS_BIAS = WS_ROPE + (size_t)4096 * 16 * 8;
constexpr size_t WS_MEMB = al(WS_BIAS + 3 * 8 * 132 * 4);
constexpr size_t WS_KVX = WS_MEMB + (size_t)2048 * 1024 * 2;
constexpr size_t WS_HB = WS_KVX + (size_t)2 * 2048 * 1024 * 2;
constexpr size_t WS_W = WS_HB + (size_t)T * 1024 * 2;
constexpr size_t WO_GU1 = 0;
constexpr size_t WO_D1 = WO_GU1 + (size_t)5632 * 1024;
constexpr size_t WO_IN = WO_D1 + (size_t)1024 * 2816;
constexpr size_t WO_UQ = WO_IN + (size_t)NINP * 1024;
constexpr size_t WO_UKV = WO_UQ + (size_t)768 * 384;
constexpr size_t WO_BA = WO_UKV + (size_t)1024 * 256;
constexpr size_t WO_BB = WO_BA + (size_t)1024 * 512;
constexpr size_t WO_BC = WO_BB + (size_t)1024 * 512;
constexpr size_t WO_MO = WO_BC + (size_t)1024 * 512;
constexpr size_t WO_XQ = WO_MO + (size_t)1024 * 1024;
constexpr size_t WO_XKV = WO_XQ + (size_t)512 * 1024;
constexpr size_t WO_XO = WO_XKV + (size_t)1024 * 1024;
constexpr size_t WO_GU2 = WO_XO + (size_t)1024 * 512;
constexpr size_t WO_D2 = WO_GU2 + (size_t)5632 * 1024;
constexpr size_t W_LAYER = WO_D2 + (size_t)1024 * 2816;
constexpr size_t WS_R1 = WS_W + 2 * W_LAYER * 2;
constexpr size_t R_P = 0;
constexpr size_t R_QM = R_P + (size_t)TC * NINP * 2;
constexpr size_t R_KVM = R_QM + (size_t)TC * 768 * 2;
constexpr size_t R_OG = R_KVM + (size_t)TC * 1024 * 2;
constexpr size_t R_M32 = R_QM;
constexpr size_t R_OA = R_OG + (size_t)3 * TC * 512 * 2;
constexpr size_t R_LSE = R_OA + (size_t)3 * TC * 512 * 2;
constexpr size_t R_MB = R_LSE + (size_t)3 * TC * 8 * 4;
constexpr size_t R_END = R_MB + (size_t)T * 1024 * 2;
constexpr size_t R_ACT = 0;
constexpr size_t R_QX = 0;
constexpr size_t R_OX = (size_t)T * 512 * 2;
static_assert((size_t)TC * 1024 * 4 <= R_OA - R_QM, "m32 alias");
static_assert((size_t)T * FF * 2 <= R_END, "act fits");
constexpr size_t WS_END = WS_R1 + R_END;
static_assert(WS_END <= (size_t)512 * 1024 * 1024, "workspace");

constexpr int LDS_BYTES = 147456;
constexpr int LDS_CTL = 131072;

namespace pg8 {
constexpr int BM = 256, BK = 64, HALF = 128, HTB = HALF * BK * 2, STAGE_BYTES = 8 * HTB, NXCD = 8, WGM = 8;
DI int lds_byte(int r, int c) { const int st = (r >> 4) * 2 + (c >> 5), rr = r & 15, cc = c & 31, ob = rr * 64 + cc * 2; return st * 1024 + (ob ^ (((ob >> 9) & 1) << 5)); }
DI void stage_rc(int b, int& R, int& C) { const int st = b / 1024, sb = b % 1024, swz = sb ^ (((sb >> 9) & 1) << 5); R = (st >> 1) * 16 + swz / 64; C = (st & 1) * 32 + (swz % 64) / 2; }
DI int perm32(int rho) { const int n = rho >> 4, i = rho & 15; return 8 * (i >> 2) + 4 * n + (i & 3); }
struct Unit { int pm, pn; };
struct Gemm { const bf16_t* A; const bf16_t* Bt; int lda, ldb, M, N, K; };
struct StaticOrder {
    int nM, nN, nwg, G, c, npass, pms, pns;
    DI void init(int M, int N, int G_, int c_) { nM = M / BM; nN = N / BM; nwg = nM * nN; G = G_; c = c_; npass = 1; pms = 0; pns = 0; }
    DI void passes(int np, int pms_, int pns_) { npass = np; pms = pms_; pns = pns_; }
    DI bool next(int i_, Unit& u) const {
        const int i = (npass == 1) ? i_ : i_ / npass, b = i_ - i * npass;
        const long L = (long)i * G + c; if (L >= nwg) return false;
        int wgid = (int)L; { const int q = nwg / NXCD, r = nwg % NXCD, xcd = wgid % NXCD, off = wgid / NXCD; wgid = (xcd < r ? xcd * (q + 1) : r * (q + 1) + (xcd - r) * q) + off; }
        const int nig = WGM * nN, gid = wgid / nig, fm = gid * WGM, gsz = (nM - fm) < WGM ? (nM - fm) : WGM;
        u.pm = fm + ((wgid % nig) % gsz) + b * pms; u.pn = (wgid % nig) / gsz + b * pns; return true;
    }
};


template <class Epi, bool HALFM = false>
DI void gemm_phase(LAS unsigned char* lds, const Gemm g, const StaticOrder& S, const Epi& E) {
    const int tid = ltid(), wid = __builtin_amdgcn_readfirstlane(tid >> 6), lane = tid & 63, wr = wid >> 2, wc = wid & 3, fr = lane & 15, fq = lane >> 4;
    const int K = g.K, nt = K / BK;
    unsigned voffA[2], voffB[2];
#pragma unroll
    for (int i = 0; i < 2; ++i) { int R, C; stage_rc(tid * 16 + i * 8192, R, C); const int Rb = (R & ~31) + perm32(R & 31);
        voffA[i] = (unsigned)(R * g.lda + C) * 2u; voffB[i] = (unsigned)(Rb * g.ldb + C) * 2u; }
    const size_t kstep = (size_t)(BK * 2);
    const size_t hstepA = (size_t)HALF * g.lda * 2, hstepB = (size_t)HALF * g.ldb * 2;
    const size_t tstepA = HALFM ? hstepA : 2 * hstepA, tstepB = 2 * hstepB;
    const unsigned ldsw = (unsigned)wid * 1024u;
    const int aoff = lds_byte(wr * 64 + fr, fq * 8), boff = lds_byte(wc * 32 + fr, fq * 8);
#define PG8_SA(b, h) (((b) * 2 + (h)) * HTB)
#define PG8_SB(b, h) ((4 + (b) * 2 + (h)) * HTB)
#define PG8_STAGE(bufoff, gbase, voff) do { _Pragma("unroll") for (int _i = 0; _i < 2; ++_i) \
        __builtin_amdgcn_global_load_lds((const unsigned*)((const char*)(gbase) + (voff)[_i]), (LAS unsigned*)(lds + (bufoff) + ldsw + _i * 8192), 16, 0, 0); } while (0)
#define PG8_LDA(dst, b, h) do { _Pragma("unroll") for (int m = 0; m < 4; ++m) _Pragma("unroll") for (int k = 0; k < 2; ++k) dst[m][k] = *(const LAS bf16x8*)(lds + PG8_SA(b, h) + aoff + m * 2048 + k * 1024); } while (0)
#define PG8_LDB(dst, b, h) do { _Pragma("unroll") for (int n = 0; n < 2; ++n) _Pragma("unroll") for (int k = 0; k < 2; ++k) dst[n][k] = *(const LAS bf16x8*)(lds + PG8_SB(b, h) + boff + n * 2048 + k * 1024); } while (0)
#define PG8_MMA(ai, bj, At, Bt) do { __builtin_amdgcn_s_setprio(1); _Pragma("unroll") for (int m = 0; m < 4; ++m) _Pragma("unroll") for (int n = 0; n < 2; ++n) _Pragma("unroll") for (int k = 0; k < 2; ++k) \
        acc[ai][bj][m][n] = __builtin_amdgcn_mfma_f32_16x16x32_bf16(Bt[n][k], At[m][k], acc[ai][bj][m][n], 0, 0, 0); __builtin_amdgcn_s_setprio(0); } while (0)
#define PG8_WAIT_V(n) asm volatile("s_waitcnt vmcnt(" #n ")" ::: "memory")
#define PG8_WAIT_L(n) asm volatile("s_waitcnt lgkmcnt(" #n ")" ::: "memory")
#define PG8_BAR __builtin_amdgcn_s_barrier()
#define PG8_SCHED __builtin_amdgcn_sched_barrier(0)
    Unit cur, nxt; int ui = 0;
    if (!S.next(0, cur)) return;
    f32x4 acc[2][2][4][2];
#pragma unroll
    for (int a = 0; a < 2; ++a)
#pragma unroll
        for (int b = 0; b < 2; ++b)
#pragma unroll
            for (int m = 0; m < 4; ++m)
#pragma unroll
                for (int n = 0; n < 2; ++n) acc[a][b][m][n] = (f32x4){0.f, 0.f, 0.f, 0.f};
    bf16x8 At[4][2], B0[2][2], B1[2][2];
    const char* cA = (const char*)g.A + (size_t)cur.pm * tstepA; const char* cB = (const char*)g.Bt + (size_t)cur.pn * tstepB;
    PG8_STAGE(PG8_SB(0, 0), cB, voffB); PG8_STAGE(PG8_SB(0, 1), cB + hstepB, voffB); PG8_STAGE(PG8_SA(0, 0), cA, voffA); PG8_STAGE(PG8_SA(0, 1), cA + hstepA, voffA);
    if (wr == 1) PG8_BAR;
    PG8_WAIT_V(2); PG8_BAR;
    PG8_STAGE(PG8_SB(1, 0), cB + kstep, voffB); PG8_STAGE(PG8_SA(1, 0), cA + kstep, voffA); PG8_STAGE(PG8_SB(1, 1), cB + hstepB + kstep, voffB);
    PG8_WAIT_V(6); PG8_BAR;
    for (;;) {
        const bool has_next = S.next(ui + 1, nxt);
        const char* nA = has_next ? (const char*)g.A + (size_t)nxt.pm * tstepA : cA; const char* nB = has_next ? (const char*)g.Bt + (size_t)nxt.pn * tstepB : cB;
#pragma unroll 1
        for (int t = 0; t < nt; t += 2) {
            const bool last = (t == nt - 2);
            const char* a1 = cA + (size_t)(t + 1) * kstep;
            const char* a2 = last ? nA : cA + (size_t)(t + 2) * kstep; const char* b2 = last ? nB : cB + (size_t)(t + 2) * kstep;
            const char* a3 = a2 + kstep; const char* b3 = b2 + kstep;
            PG8_LDB(B0, 0, 0); PG8_LDB(B1, 0, 1); PG8_SCHED; PG8_LDA(At, 0, 0); PG8_STAGE(PG8_SA(1, 1), a1 + hstepA, voffA);
            PG8_WAIT_V(8); PG8_WAIT_L(0); PG8_BAR; PG8_MMA(0, 0, At, B0); PG8_MMA(0, 1, At, B1); PG8_BAR; PG8_SCHED;
            if constexpr (!HALFM) PG8_LDA(At, 0, 1);
            PG8_STAGE(PG8_SB(0, 0), b2, voffB); PG8_STAGE(PG8_SB(0, 1), b2 + hstepB, voffB); PG8_STAGE(PG8_SA(0, 0), a2, voffA);
            PG8_WAIT_V(8); PG8_WAIT_L(0); PG8_BAR; if constexpr (!HALFM) { PG8_MMA(1, 0, At, B0); PG8_MMA(1, 1, At, B1); } PG8_BAR; PG8_SCHED;
            PG8_LDB(B0, 1, 0); PG8_LDB(B1, 1, 1); PG8_SCHED; PG8_LDA(At, 1, 0); PG8_STAGE(PG8_SA(0, 1), a2 + hstepA, voffA);
            PG8_WAIT_V(8); PG8_WAIT_L(0); PG8_BAR; PG8_MMA(0, 0, At, B0); PG8_MMA(0, 1, At, B1); PG8_BAR; PG8_SCHED;
            if constexpr (!HALFM) PG8_LDA(At, 1, 1);
            PG8_STAGE(PG8_SB(1, 0), b3, voffB); PG8_STAGE(PG8_SB(1, 1), b3 + hstepB, voffB); PG8_STAGE(PG8_SA(1, 0), a3, voffA);
            PG8_WAIT_V(8); PG8_WAIT_L(0); PG8_BAR; if constexpr (!HALFM) { PG8_MMA(1, 0, At, B0); PG8_MMA(1, 1, At, B1); } PG8_BAR; PG8_SCHED;
        }
        if (wr == 0) PG8_BAR;
        { const int l2 = ltid() & 63; E(acc, cur, wr, wc, l2 & 15, l2 >> 4); }
        if (!has_next) break;
#pragma unroll
        for (int a = 0; a < (HALFM ? 1 : 2); ++a)
#pragma unroll
            for (int b = 0; b < 2; ++b)
#pragma unroll
                for (int m = 0; m < 4; ++m)
#pragma unroll
                    for (int n = 0; n < 2; ++n) acc[a][b][m][n] = (f32x4){0.f, 0.f, 0.f, 0.f};
        cur = nxt; cA = nA; cB = nB; ++ui;
        if (wr == 1) PG8_BAR;
    }
    PG8_WAIT_V(0);
    PG8_BAR;
#undef PG8_SA
#undef PG8_SB
#undef PG8_STAGE
#undef PG8_LDA
#undef PG8_LDB
#undef PG8_MMA
#undef PG8_WAIT_V
#undef PG8_WAIT_L
#undef PG8_BAR
#undef PG8_SCHED
}

template <int MODE> struct EpiScaled {
    bf16_t* O; int ldc; const float* ss; float inv_dim; float* ss_cq; float* ss_ckv; const float* rope;
    DI void operator()(const f32x4 (&acc)[2][2][4][2], const Unit& u, int wr, int wc, int fr, int fq) const {
        const int row0 = u.pm * BM + wr * 64 + fr, col0 = u.pn * BM + wc * 32 + 8 * fq;
        float ssv[2][4];
#pragma unroll
        for (int ai = 0; ai < 2; ++ai)
#pragma unroll
            for (int m = 0; m < 4; ++m) ssv[ai][m] = ss ? ss[row0 + ai * HALF + m * 16] : 0.f;
#pragma unroll
        for (int ai = 0; ai < 2; ++ai)
#pragma unroll
            for (int m = 0; m < 4; ++m) {
                const int r = row0 + ai * HALF + m * 16;
                const float rs = ss ? __builtin_amdgcn_rsqf(ssv[ai][m] * inv_dim + EPS) : 1.f;
#pragma unroll
                for (int bj = 0; bj < 2; ++bj) {
                    float v[8];
#pragma unroll
                    for (int j = 0; j < 4; ++j) { v[j] = acc[ai][bj][m][0][j] * rs; v[4 + j] = acc[ai][bj][m][1][j] * rs; }
                    bool do_rope = false;
                    if (MODE == 1) {
                        const bool cq = (u.pn == 6) || (u.pn == 7 && bj == 0), ckv = (u.pn == 7 && bj == 1);
                        if (cq || ckv) {
                            float q = 0.f;
#pragma unroll
                            for (int j = 0; j < 8; ++j) q += v[j] * v[j];
                            q += __shfl_xor(q, 16); q += __shfl_xor(q, 32);
                            if (fq == 0) unsafeAtomicAdd((cq ? ss_cq : ss_ckv) + r, q);
                        }
                        do_rope = (u.pn == 8 && bj == 0 && wc == 0);
                    }
                    if (MODE == 2) { const int g32 = (u.pn * BM + bj * HALF + wc * 32) >> 5; do_rope = (g32 % 3) == 2; }
                    if (MODE != 0 && do_rope) {
                        const int pos = r & (SEQ - 1);
                        const f32x4* cs = (const f32x4*)(rope + ((size_t)pos * 16 + 8 * (fq & 1)) * 2);
#pragma unroll
                        for (int jj = 0; jj < 4; ++jj) {
                            const f32x4 c4 = cs[jj];
                            const float p0 = __shfl_xor(v[2 * jj], 32), p1 = __shfl_xor(v[2 * jj + 1], 32);
                            if (fq < 2) { v[2 * jj] = v[2 * jj] * c4[0] - p0 * c4[1]; v[2 * jj + 1] = v[2 * jj + 1] * c4[2] - p1 * c4[3]; }
                            else        { v[2 * jj] = p0 * c4[1] + v[2 * jj] * c4[0]; v[2 * jj + 1] = p1 * c4[3] + v[2 * jj + 1] * c4[2]; }
                        }
                    }
                    u32x4 w; w.x = pk2(v[0], v[1]); w.y = pk2(v[2], v[3]); w.z = pk2(v[4], v[5]); w.w = pk2(v[6], v[7]);
                    *(u32x4*)(O + (size_t)r * ldc + col0 + bj * HALF) = w;
                }
                asm volatile("" ::: "memory");
            }
    }
};

struct EpiSwiglu {
    bf16_t* O; int ldc; const float* ss;
    DI void operator()(const f32x4 (&acc)[2][2][4][2], const Unit& u, int wr, int wc, int fr, int fq) const {
        const int row0 = u.pm * BM + wr * 64 + fr, col0 = u.pn * 128 + wc * 32 + 8 * fq;
        float ssv[2][4];
#pragma unroll
        for (int ai = 0; ai < 2; ++ai)
#pragma unroll
            for (int m = 0; m < 4; ++m) ssv[ai][m] = ss[row0 + ai * HALF + m * 16];
#pragma unroll
        for (int ai = 0; ai < 2; ++ai)
#pragma unroll
            for (int m = 0; m < 4; ++m) {
                const int r = row0 + ai * HALF + m * 16;
                const float rs = __builtin_amdgcn_rsqf(ssv[ai][m] * (1.0f / 1024.0f) + EPS);
                float o[8];
#pragma unroll
                for (int n = 0; n < 2; ++n)
#pragma unroll
                    for (int e = 0; e < 4; ++e) { const float gg = acc[ai][0][m][n][e] * rs, uu = acc[ai][1][m][n][e] * rs; o[4 * n + e] = gg * sigmoidf_(gg) * uu; }
                u32x4 w; w.x = pk2(o[0], o[1]); w.y = pk2(o[2], o[3]); w.z = pk2(o[4], o[5]); w.w = pk2(o[6], o[7]);
                *(u32x4*)(O + (size_t)r * ldc + col0) = w;
                asm volatile("" ::: "memory");
            }
    }
};

struct EpiResid {
    const float* hin; float* hout; bf16_t* hb; float* ss_out; float scale;
    DI void operator()(const f32x4 (&acc)[2][2][4][2], const Unit& u, int wr, int wc, int fr, int fq) const {
        const int row0 = u.pm * BM + wr * 64 + fr, col0 = u.pn * BM + wc * 32 + 8 * fq;
        f32x4 hn[4][2][2];
#pragma unroll
        for (int g = 0; g < 4; ++g)
#pragma unroll
            for (int bj = 0; bj < 2; ++bj) { const size_t off = (size_t)(row0 + g * 16) * DM + col0 + bj * HALF; hn[g][bj][0] = *(const f32x4*)(hin + off); hn[g][bj][1] = *(const f32x4*)(hin + off + 4); }
#pragma unroll
        for (int ai = 0; ai < 2; ++ai)
#pragma unroll
            for (int m = 0; m < 4; ++m) {
                const int r = row0 + ai * HALF + m * 16;
                f32x4 hc[2][2];
#pragma unroll
                for (int bj = 0; bj < 2; ++bj) { hc[bj][0] = hn[m][bj][0]; hc[bj][1] = hn[m][bj][1]; }
                if (ai == 0) {
                    const int rn = row0 + HALF + m * 16;
#pragma unroll
                    for (int bj = 0; bj < 2; ++bj) { const size_t off = (size_t)rn * DM + col0 + bj * HALF; hn[m][bj][0] = *(const f32x4*)(hin + off); hn[m][bj][1] = *(const f32x4*)(hin + off + 4); }
                }
                float q = 0.f;
#pragma unroll
                for (int bj = 0; bj < 2; ++bj) {
                    const size_t off = (size_t)r * DM + col0 + bj * HALF;
                    f32x4 h0 = hc[bj][0], h1 = hc[bj][1];
                    h0 += acc[ai][bj][m][0] * scale; h1 += acc[ai][bj][m][1] * scale;
                    *(f32x4*)(hout + off) = h0; *(f32x4*)(hout + off + 4) = h1;
                    u32x4 w; w.x = pk2(h0[0], h0[1]); w.y = pk2(h0[2], h0[3]); w.z = pk2(h1[0], h1[1]); w.w = pk2(h1[2], h1[3]);
                    if (hb) *(u32x4*)(hb + off) = w;
                    q += h0[0] * h0[0] + h0[1] * h0[1] + h0[2] * h0[2] + h0[3] * h0[3] + h1[0] * h1[0] + h1[1] * h1[1] + h1[2] * h1[2] + h1[3] * h1[3];
                }
                q += __shfl_xor(q, 16); q += __shfl_xor(q, 32);
                if (fq == 0) unsafeAtomicAdd(ss_out + r, q);
                asm volatile("" ::: "memory");
            }
    }
};

struct EpiGate {
    const bf16_t* gate0; int ldg; const float* bias0; float* m32; bf16_t* mb;
    DI void operator()(f32x4 (&acc)[2][2][4][2], const Unit& u, int wr, int wc, int fr, int fq) const {
        const int b = u.pm / (TC / HALF), pm = u.pm - b * (TC / HALF), pn = u.pn - b * 4;
        const bool first = (b == 0), last = (b == 2);
        const bf16_t* gate = gate0 + b * 1024; const float* bias = bias0 + b * 1024;
        const int row0 = pm * HALF + wr * 64 + fr, col0 = pn * BM + wc * 32 + 8 * fq;
        f32x4 bz[2][2]; u32x4 gall[4][2];
#pragma unroll
        for (int bj = 0; bj < 2; ++bj) { bz[bj][0] = *(const f32x4*)(bias + col0 + bj * HALF); bz[bj][1] = *(const f32x4*)(bias + col0 + bj * HALF + 4); }
#pragma unroll
        for (int m = 0; m < 4; ++m)
#pragma unroll
            for (int bj = 0; bj < 2; ++bj) gall[m][bj] = *(const u32x4*)(gate + (size_t)(row0 + m * 16) * ldg + col0 + bj * HALF);
#pragma unroll
        for (int ai = 0; ai < 1; ++ai)
#pragma unroll
            for (int m = 0; m < 4; ++m) {
                const int r = row0 + ai * HALF + m * 16;
#pragma unroll
                for (int bj = 0; bj < 2; ++bj) {
                    const int c = col0 + bj * HALF;
                    const u32x4 gw = gall[m][bj];
                    const f32x4 b0 = bz[bj][0], b1 = bz[bj][1];
                    f32x4 v0, v1;
                    v0[0] = acc[ai][bj][m][0][0] * sigmoidf_(bflo(gw.x) + b0[0]); v0[1] = acc[ai][bj][m][0][1] * sigmoidf_(bfhi(gw.x) + b0[1]);
                    v0[2] = acc[ai][bj][m][0][2] * sigmoidf_(bflo(gw.y) + b0[2]); v0[3] = acc[ai][bj][m][0][3] * sigmoidf_(bfhi(gw.y) + b0[3]);
                    v1[0] = acc[ai][bj][m][1][0] * sigmoidf_(bflo(gw.z) + b1[0]); v1[1] = acc[ai][bj][m][1][1] * sigmoidf_(bfhi(gw.z) + b1[1]);
                    v1[2] = acc[ai][bj][m][1][2] * sigmoidf_(bflo(gw.w) + b1[2]); v1[3] = acc[ai][bj][m][1][3] * sigmoidf_(bfhi(gw.w) + b1[3]);
                    const size_t off = (size_t)r * DM + c;
                    if (!first) { v0 += acc[1][bj][m][0]; v1 += acc[1][bj][m][1]; }
                    if (!last) { acc[1][bj][m][0] = v0; acc[1][bj][m][1] = v1; }
                    else { u32x4 w; w.x = pk2(v0[0], v0[1]); w.y = pk2(v0[2], v0[3]); w.z = pk2(v1[0], v1[1]); w.w = pk2(v1[2], v1[3]); *(u32x4*)(mb + off) = w; }
                    asm volatile("" ::: "memory");
                }
            }
    }
};
}

struct AttnArgs {
    const bf16_t* Q; int ldq;
    const bf16_t* K; int ldk;
    const bf16_t* K2; int ldk2;
    const bf16_t* V; int ldv;
    bf16_t* O; int ldo;
    float* lse; int ldl;
    int q0, tstride, toff, nk;
    float c2;
    const float* biasg;
};
DI int crow(int i, int hh) { return (i & 3) + 8 * (i >> 2) + 4 * hh; }
#define MFMA32(a, b, c) __builtin_amdgcn_mfma_f32_32x32x16_bf16((a), (b), (c), 0, 0, 0)

template <int MODE> struct ACfg;
template <> struct ACfg<0> { static constexpr int DK = 128, DV = 128; };
template <> struct ACfg<1> { static constexpr int DK = 96, DV = 64; };
template <> struct ACfg<2> { static constexpr int DK = 64, DV = 64; };
template <> struct ACfg<3> { static constexpr int DK = 64, DV = 64; };

DI bf16x8 pack8(const f32x16& x, int s) {
    u32x4 p;
    p.x = pk2(x[8 * s + 0], x[8 * s + 1]); p.y = pk2(x[8 * s + 2], x[8 * s + 3]); p.z = pk2(x[8 * s + 4], x[8 * s + 5]); p.w = pk2(x[8 * s + 6], x[8 * s + 7]);
    return __builtin_bit_cast(bf16x8, p);
}

template <bool MASKED>
DI void sb_block(f32x16& s, int kb0, int qi, int hh, float c2, float& carry) {
    float kp[16], bt[16];
#pragma unroll
    for (int i = 0; i < 16; ++i) {
        const float t = ex2(-fabsf(s[i]) * c2);
        const float r = __builtin_amdgcn_rcpf(1.0f + t), tr = t * r;
        const bool pos = s[i] >= 0.f;
        float b = pos ? r : tr, k = pos ? tr : r;
        if (MASKED) { const bool valid = (kb0 + crow(i, hh)) < qi; b = valid ? b : 0.f; k = valid ? k : 1.f; }
        bt[i] = b; kp[i] = k;
    }
    float gs[4], pg[4];
#pragma unroll
    for (int q = 0; q < 4; ++q) gs[q] = (kp[4 * q] * kp[4 * q + 1]) * (kp[4 * q + 2] * kp[4 * q + 3]);
#pragma unroll
    for (int q = 0; q < 4; ++q) pg[q] = __shfl_xor(gs[q], 32);
    float run = carry;
#pragma unroll
    for (int q = 3; q >= 0; --q) {
        const float a3 = (hh == 0) ? run * pg[q] : run;
        const float a2 = a3 * kp[4 * q + 3], a1 = a2 * kp[4 * q + 2], a0 = a1 * kp[4 * q + 1];
        s[4 * q + 0] = bt[4 * q + 0] * a0; s[4 * q + 1] = bt[4 * q + 1] * a1; s[4 * q + 2] = bt[4 * q + 2] * a2; s[4 * q + 3] = bt[4 * q + 3] * a3;
        run *= gs[q] * pg[q];
    }
    carry = run;
}

template <int MODE>
DI void attn_unit(LAS unsigned char* lds, const AttnArgs a) {
    constexpr int DK = ACfg<MODE>::DK, DV = ACfg<MODE>::DV, KLD = DK + 8, VLD = 72, NKS = DK / 16, NDB = DV / 32;
    const int tid = ltid(), wid = __builtin_amdgcn_readfirstlane(tid >> 6), lane = tid & 63, r32 = lane & 31, hh = lane >> 5;
    constexpr bool SWZ = (DV == 64);
    constexpr int BUFE = 64 * KLD + DV * VLD;
    LAS bf16_t* Ks = (LAS bf16_t*)lds;
    LAS bf16_t* Vt = Ks + 64 * KLD;
    LAS float* biasL = (LAS float*)(Ks + 2 * BUFE);
    const int q0w = a.q0 + wid * 32, qi = q0w + r32;
    const size_t qtok = (size_t)a.toff + (size_t)qi * a.tstride;
    bf16x8 qf[NKS];
#pragma unroll
    for (int ks = 0; ks < NKS; ++ks) qf[ks] = *(const bf16x8*)(a.Q + qtok * a.ldq + ks * 16 + 8 * hh);
    if (MODE == 3) { __syncthreads(); if (tid < 129) biasL[tid] = a.biasg[tid]; }
    f32x16 o[NDB];
#pragma unroll
    for (int d = 0; d < NDB; ++d)
#pragma unroll
        for (int i = 0; i < 16; ++i) o[d][i] = 0.f;
    float mrow = -1e30f, lrow = 0.f, carry = 1.f;
    int ntile;
    if (MODE == 0) ntile = a.nk / 64; else if (MODE == 1) ntile = (a.q0 + 255) / 64 + 1; else if (MODE == 2) ntile = (a.q0 + 254) / 64 + 1; else ntile = 6;
    const int it0 = (MODE == 3 && a.q0 == 0) ? 2 : 0;
    constexpr int NKC = (64 * (DK / 8) + 511) / 512, NVC = (64 * (DV / 8) + 511) / 512;
    u32x4 kreg[NKC], vreg[NVC];
#define ATT_KBASE(it_) ((MODE == 2) ? (ntile - 1 - (it_)) * 64 : ((MODE == 3) ? a.q0 - 128 + (it_) * 64 : (it_) * 64))
#define ATT_LOAD(it_) do { const int kb_ = ATT_KBASE(it_); \
        _Pragma("unroll") for (int i_ = 0; i_ < NKC; ++i_) { const int c = tid + i_ * 512; if (c < 64 * (DK / 8)) { \
            const int row = c / (DK / 8), ch = c % (DK / 8); int kj = kb_ + row; if (MODE == 3) kj = kj < 0 ? 0 : kj; \
            const size_t tok = (size_t)a.toff + (size_t)kj * a.tstride; \
            const bf16_t* src = (MODE == 1 && ch >= 8) ? (a.K2 + tok * a.ldk2 + (ch - 8) * 8) : (a.K + tok * a.ldk + ch * 8); \
            kreg[i_] = *(const u32x4*)src; } } \
        _Pragma("unroll") for (int i_ = 0; i_ < NVC; ++i_) { const int c = tid + i_ * 512; \
            const int row = c / (DV / 8), ch = c % (DV / 8); int kj = kb_ + row; if (MODE == 3) kj = kj < 0 ? 0 : kj; \
            const size_t tok = (size_t)a.toff + (size_t)kj * a.tstride; \
            vreg[i_] = *(const u32x4*)(a.V + tok * a.ldv + ch * 8); } } while (0)
#define ATT_STORE(b_) do { LAS bf16_t* Kd = Ks + (b_) * BUFE; LAS bf16_t* Vd = Vt + (b_) * BUFE; \
        _Pragma("unroll") for (int i_ = 0; i_ < NKC; ++i_) { const int c = tid + i_ * 512; if (c < 64 * (DK / 8)) { const int row = c / (DK / 8), ch = c % (DK / 8); *(LAS u32x4*)(Kd + row * KLD + ch * 8) = kreg[i_]; } } \
        _Pragma("unroll") for (int i_ = 0; i_ < NVC; ++i_) { \
            const int c = tid + i_ * 512, row = c / (DV / 8), ch = c % (DV / 8); \
            const u32x4 v = vreg[i_]; \
            LAS bf16_t* dst = Vd + (ch * 8) * VLD + (row ^ (SWZ ? ((ch & 7) << 2) : 0));   \
            dst[0 * VLD] = (bf16_t)(v.x & 0xffff); dst[1 * VLD] = (bf16_t)(v.x >> 16); \
            dst[2 * VLD] = (bf16_t)(v.y & 0xffff); dst[3 * VLD] = (bf16_t)(v.y >> 16); \
            dst[4 * VLD] = (bf16_t)(v.z & 0xffff); dst[5 * VLD] = (bf16_t)(v.z >> 16); \
            dst[6 * VLD] = (bf16_t)(v.w & 0xffff); dst[7 * VLD] = (bf16_t)(v.w >> 16); } } while (0)
    ATT_LOAD(it0);
    ATT_STORE(0);
    __syncthreads();
    if (it0 + 1 < ntile) ATT_LOAD(it0 + 1);
    bool sb_dead = false;
    for (int it = it0; it < ntile; ++it) {
        const int kbase = ATT_KBASE(it), cur = (it - it0) & 1;
        const LAS bf16_t* Kc = Ks + cur * BUFE; const LAS bf16_t* Vc = Vt + cur * BUFE;
        bool active = true;
        if (MODE == 1) active = kbase <= q0w + 31;
        if (MODE == 2) active = (kbase <= q0w + 30) && !sb_dead;
        if (MODE == 3) active = (kbase + 63 >= q0w - 128) && (kbase <= q0w + 31);
        if (active) {
        f32x16 s0, s1;
#pragma unroll
        for (int i = 0; i < 16; ++i) { s0[i] = 0.f; s1[i] = 0.f; }
#pragma unroll
        for (int ks = 0; ks < NKS; ++ks) {
            const bf16x8 a0 = *(const LAS bf16x8*)(Kc + r32 * KLD + ks * 16 + 8 * hh);
            const bf16x8 a1 = *(const LAS bf16x8*)(Kc + (32 + r32) * KLD + ks * 16 + 8 * hh);
            s0 = MFMA32(a0, qf[ks], s0); s1 = MFMA32(a1, qf[ks], s1);
        }
        if (MODE == 2) {
            if (kbase + 63 < q0w) { sb_block<false>(s1, kbase + 32, qi, hh, a.c2, carry); sb_block<false>(s0, kbase, qi, hh, a.c2, carry); }
            else                  { sb_block<true>(s1, kbase + 32, qi, hh, a.c2, carry);  sb_block<true>(s0, kbase, qi, hh, a.c2, carry); }
        } else {
            const bool interior = (MODE == 0) || (MODE == 1 && kbase + 63 <= q0w);
            float mnew, alpha, ls = 0.f;
            if (interior) {
#pragma unroll
                for (int i = 0; i < 16; ++i) { s0[i] *= a.c2; s1[i] *= a.c2; }
                float mx = max3f(s0[0], s1[0], s0[1]);
                mx = max3f(mx, s1[1], s0[2]); mx = max3f(mx, s1[2], s0[3]); mx = max3f(mx, s1[3], s0[4]); mx = max3f(mx, s1[4], s0[5]);
                mx = max3f(mx, s1[5], s0[6]); mx = max3f(mx, s1[6], s0[7]); mx = max3f(mx, s1[7], s0[8]); mx = max3f(mx, s1[8], s0[9]);
                mx = max3f(mx, s1[9], s0[10]); mx = max3f(mx, s1[10], s0[11]); mx = max3f(mx, s1[11], s0[12]); mx = max3f(mx, s1[12], s0[13]);
                mx = max3f(mx, s1[13], s0[14]); mx = max3f(mx, s1[14], s0[15]); mx = fmaxf(mx, s1[15]);
                mx = fmaxf(mx, __shfl_xor(mx, 32));
                mnew = fmaxf(mrow, mx); alpha = ex2(mrow - mnew);
#pragma unroll
                for (int i = 0; i < 16; ++i) {
                    const float p0 = ex2(s0[i] - mnew), p1 = ex2(s1[i] - mnew);
                    s0[i] = p0; s1[i] = p1; ls += p0 + p1;
                }
            } else {
                float mx = -1e30f;
#pragma unroll
                for (int i = 0; i < 16; ++i) {
                    const int k0 = kbase + crow(i, hh), k1 = k0 + 32;
                    float x0 = s0[i] * a.c2, x1 = s1[i] * a.c2;
                    bool v0 = true, v1 = true;
                    if (MODE == 1) { v0 = k0 <= qi; v1 = k1 <= qi; }
                    if (MODE == 3) {
                        const int st0 = qi - k0, st1 = qi - k1;
                        v0 = (st0 >= 0) && (st0 <= 128) && (k0 >= 0); v1 = (st1 >= 0) && (st1 <= 128) && (k1 >= 0);
                        x0 += biasL[min(max(st0, 0), 128)]; x1 += biasL[min(max(st1, 0), 128)];
                    }
                    x0 = v0 ? x0 : -1e30f; x1 = v1 ? x1 : -1e30f;
                    s0[i] = x0; s1[i] = x1; mx = fmaxf(mx, fmaxf(x0, x1));
                }
                mx = fmaxf(mx, __shfl_xor(mx, 32));
                mnew = fmaxf(mrow, mx); alpha = ex2(mrow - mnew);
#pragma unroll
                for (int i = 0; i < 16; ++i) {
                    const float p0 = (s0[i] > -1e29f) ? ex2(s0[i] - mnew) : 0.f, p1 = (s1[i] > -1e29f) ? ex2(s1[i] - mnew) : 0.f;
                    s0[i] = p0; s1[i] = p1; ls += p0 + p1;
                }
            }
            mrow = mnew;
            lrow = lrow * alpha + ls;
            if (__ballot(alpha < 1.0f) != 0ull) {
#pragma unroll
                for (int d = 0; d < NDB; ++d)
#pragma unroll
                    for (int i = 0; i < 16; ++i) o[d][i] *= alpha;
            }
        }
        const bf16x8 pb00 = pack8(s0, 0), pb01 = pack8(s0, 1), pb10 = pack8(s1, 0), pb11 = pack8(s1, 1);
#pragma unroll
        for (int d = 0; d < NDB; ++d) {
            const LAS bf16_t* vp = Vc + (d * 32 + r32) * VLD;
            const int sw = SWZ ? ((((d * 32 + r32) >> 3) & 7) << 2) : 0;
#define VFRAG(off) __builtin_shufflevector(*(const LAS s16x4*)(vp + (((off) + 4 * hh) ^ sw)), *(const LAS s16x4*)(vp + (((off) + 8 + 4 * hh) ^ sw)), 0, 1, 2, 3, 4, 5, 6, 7)
            o[d] = MFMA32(VFRAG(0), pb00, o[d]);
            o[d] = MFMA32(VFRAG(16), pb01, o[d]);
            o[d] = MFMA32(VFRAG(32), pb10, o[d]);
            o[d] = MFMA32(VFRAG(48), pb11, o[d]);
#undef VFRAG
        }
        }
        if (it + 1 < ntile) ATT_STORE(cur ^ 1);
        if (MODE == 2) {
            sb_dead = (__ballot(carry != 0.f) == 0ull);
            if (!__syncthreads_or(sb_dead ? 0 : 1)) break;
        } else __syncthreads();
        if (it + 2 < ntile) ATT_LOAD(it + 2);
    }
    float inv = 1.f;
    if (MODE != 2) {
        const float lt = lrow + __shfl_xor(lrow, 32);
        inv = 1.0f / lt;
        if (MODE == 3 && hh == 0) a.lse[qtok * a.ldl] = mrow + lg2(lt);
    }
#pragma unroll
    for (int d = 0; d < NDB; ++d)
#pragma unroll
        for (int g4 = 0; g4 < 4; ++g4) {
            u32x2 w; w.x = pk2(o[d][4 * g4] * inv, o[d][4 * g4 + 1] * inv); w.y = pk2(o[d][4 * g4 + 2] * inv, o[d][4 * g4 + 3] * inv);
            *(u32x2*)(a.O + qtok * a.ldo + d * 32 + 8 * g4 + 4 * hh) = w;
        }
}

DI void attn_dil_unit(LAS unsigned char* lds, const AttnArgs a) {
    constexpr int KLD = 72, VLD = 392, NK = 384;
    const int tid = ltid(), wid = __builtin_amdgcn_readfirstlane(tid >> 6), lane = tid & 63, r32 = lane & 31, hh = lane >> 5;
    LAS bf16_t* Kl = (LAS bf16_t*)lds;
    LAS bf16_t* Vl = Kl + NK * KLD;
    LAS float* biasL = (LAS float*)(Vl + 64 * VLD);
    const int q0w = a.q0 + wid * 32, qi = q0w + r32;
    const size_t qtok = (size_t)a.toff + (size_t)qi * a.tstride;
    bf16x8 qf[4];
#pragma unroll
    for (int ks = 0; ks < 4; ++ks) qf[ks] = *(const bf16x8*)(a.Q + qtok * a.ldq + ks * 16 + 8 * hh);
    {
        u32x4 kr[6], vr[6];
#pragma unroll
        for (int i = 0; i < 6; ++i) {
            const int c = tid + 512 * i, row = c >> 3, ch = c & 7;
            int kj = a.q0 - 128 + row; kj = kj < 0 ? 0 : kj;
            const size_t tok = (size_t)a.toff + (size_t)kj * a.tstride;
            kr[i] = *(const u32x4*)(a.K + tok * a.ldk + ch * 8);
            vr[i] = *(const u32x4*)(a.V + tok * a.ldv + ch * 8);
        }
        const float bv = (tid < 129) ? a.biasg[tid] : 0.f;
        __syncthreads();
        if (tid < 129) biasL[tid] = bv;
#pragma unroll
        for (int i = 0; i < 6; ++i) {
            const int c = tid + 512 * i, row = c >> 3, ch = c & 7;
            *(LAS u32x4*)(Kl + row * KLD + ch * 8) = kr[i];
            const u32x4 v = vr[i];
            LAS bf16_t* dst = Vl + (ch * 8) * VLD + (row ^ (ch << 2));
            dst[0 * VLD] = (bf16_t)(v.x & 0xffff); dst[1 * VLD] = (bf16_t)(v.x >> 16);
            dst[2 * VLD] = (bf16_t)(v.y & 0xffff); dst[3 * VLD] = (bf16_t)(v.y >> 16);
            dst[4 * VLD] = (bf16_t)(v.z & 0xffff); dst[5 * VLD] = (bf16_t)(v.z >> 16);
            dst[6 * VLD] = (bf16_t)(v.w & 0xffff); dst[7 * VLD] = (bf16_t)(v.w >> 16);
        }
    }
    __syncthreads();
    f32x16 sc[5];
#pragma unroll
    for (int j = 0; j < 5; ++j) {
#pragma unroll
        for (int i = 0; i < 16; ++i) sc[j][i] = 0.f;
#pragma unroll
        for (int ks = 0; ks < 4; ++ks) {
            const bf16x8 kf = *(const LAS bf16x8*)(Kl + (32 * wid + 32 * j + r32) * KLD + ks * 16 + 8 * hh);
            sc[j] = MFMA32(kf, qf[ks], sc[j]);
        }
    }
    float mx = -1e30f;
#pragma unroll
    for (int j = 0; j < 5; ++j)
#pragma unroll
        for (int i = 0; i < 16; ++i) {
            const int st = r32 + 128 - 32 * j - crow(i, hh);
            const int kj = qi - st;
            const bool valid = (st >= 0) && (st <= 128) && (kj >= 0);
            float x = sc[j][i] * a.c2 + biasL[min(max(st, 0), 128)];
            x = valid ? x : -1e30f;
            sc[j][i] = x; mx = fmaxf(mx, x);
        }
    mx = fmaxf(mx, __shfl_xor(mx, 32));
    float ls = 0.f;
#pragma unroll
    for (int j = 0; j < 5; ++j)
#pragma unroll
        for (int i = 0; i < 16; ++i) { const float p = (sc[j][i] > -1e29f) ? ex2(sc[j][i] - mx) : 0.f; sc[j][i] = p; ls += p; }
    const float lt = ls + __shfl_xor(ls, 32);
    f32x16 o[2];
#pragma unroll
    for (int d = 0; d < 2; ++d)
#pragma unroll
        for (int i = 0; i < 16; ++i) o[d][i] = 0.f;
#pragma unroll
    for (int j = 0; j < 5; ++j) {
        const bf16x8 pb0 = pack8(sc[j], 0), pb1 = pack8(sc[j], 1);
#pragma unroll
        for (int d = 0; d < 2; ++d) {
            const LAS bf16_t* vp = Vl + (d * 32 + r32) * VLD + 32 * wid + 32 * j;
            const int sw = (((d * 32 + r32) >> 3) & 7) << 2;
#define VFRAG2(off) __builtin_shufflevector(*(const LAS s16x4*)(vp + (((off) + 4 * hh) ^ sw)), *(const LAS s16x4*)(vp + (((off) + 8 + 4 * hh) ^ sw)), 0, 1, 2, 3, 4, 5, 6, 7)
            o[d] = MFMA32(VFRAG2(0), pb0, o[d]);
            o[d] = MFMA32(VFRAG2(16), pb1, o[d]);
#undef VFRAG2
        }
    }
    const float inv = 1.0f / lt;
    if (hh == 0) a.lse[qtok * a.ldl] = mx + lg2(lt);
#pragma unroll
    for (int d = 0; d < 2; ++d)
#pragma unroll
        for (int g4 = 0; g4 < 4; ++g4) {
            u32x2 w; w.x = pk2(o[d][4 * g4] * inv, o[d][4 * g4 + 1] * inv); w.y = pk2(o[d][4 * g4 + 2] * inv, o[d][4 * g4 + 3] * inv);
            *(u32x2*)(a.O + qtok * a.ldo + d * 32 + 8 * g4 + 4 * hh) = w;
        }
}

struct Params { const float* in[28]; float* out; unsigned char* ws; int ph_lo, ph_hi; };
typedef const __attribute__((address_space(4))) unsigned char* kptr_t;
#define KIN(i) (*(const float* const __attribute__((address_space(4)))*)(kb + 8 * (i)))
#define KOUT (*(float* const __attribute__((address_space(4)))*)(kb + 224))
#define KWS (*(unsigned char* const __attribute__((address_space(4)))*)(kb + 232))


DI float wave_sum(float v) {
#pragma unroll
    for (int o = 32; o >= 1; o >>= 1) v += __shfl_xor(v, o);
    return v;
}

struct WDesc { const float* s0; const float* s1; const float* gain; bf16_t* dst; int nrows, kdst, ksrc, ldsrc, map; };

DI int convert_weight(LAS unsigned char* lds, const WDesc d, int G, int bid, int goff) {
    LAS bf16_t* tl = (LAS bf16_t*)lds;
    const int tid = ltid();
    const int nkt = d.kdst / 64, ntile = (d.nrows / 64) * nkt;
    const int ngrp = (ntile + 3) >> 2;
    int g0 = (bid - goff) % G; if (g0 < 0) g0 += G;
    for (int t0 = g0 * 4; t0 < ntile; t0 += G * 4) {
        float v[4][8];
#pragma unroll
        for (int j = 0; j < 4; ++j) {
            const int t = t0 + j, tc = t / nkt, tk = t % nkt;
            const int cc = tid & 63, c = tc * 64 + cc;
            int col; const float* src = d.s0;
            if (d.map == 0) col = c;
            else if (d.map == 1) { col = (c >> 8) * 128 + (c & 127); if (c & 128) src = d.s1; }
            else { col = c < 2080 ? c : (c < 2304 ? -1 : c - 224); }
#pragma unroll
            for (int i = 0; i < 8; ++i) {
                const int kk = (tid >> 6) + 8 * i, k = tk * 64 + kk;
                float x = 0.f;
                if (t < ntile && col >= 0 && k < d.ksrc) { x = src[(size_t)k * d.ldsrc + col]; if (d.gain) x *= d.gain[k]; }
                v[j][i] = x;
            }
        }
        __syncthreads();
#pragma unroll
        for (int j = 0; j < 4; ++j)
#pragma unroll
            for (int i = 0; i < 8; ++i) tl[j * 64 * 66 + (tid & 63) * 66 + (tid >> 6) + 8 * i] = (bf16_t)(pk2(v[j][i], 0.f) & 0xffff);
        __syncthreads();
#pragma unroll
        for (int j = 0; j < 4; ++j) {
            const int t = t0 + j, tc = t / nkt, tk = t % nkt;
            const int rr = tid >> 3, kc = tid & 7;
            const LAS unsigned* sp = (const LAS unsigned*)(tl + j * 64 * 66 + rr * 66 + kc * 8);
            u32x4 w; w.x = sp[0]; w.y = sp[1]; w.z = sp[2]; w.w = sp[3];
            if (t < ntile) *(u32x4*)(d.dst + (size_t)(tc * 64 + rr) * d.kdst + tk * 64 + kc * 8) = w;
        }
    }
    return goff + ngrp;
}

DI WDesc wdesc(kptr_t kb, bf16_t* wl, int l, int id) {
    WDesc d; d.s1 = nullptr; d.gain = nullptr; d.map = 0;
    switch (id) {
    case 0: d.s0 = KIN(3) + (size_t)l * 1024 * 2816; d.s1 = KIN(4) + (size_t)l * 1024 * 2816; d.gain = KIN(2) + l * 1024; d.dst = wl + WO_GU1; d.nrows = 5632; d.kdst = 1024; d.ksrc = 1024; d.ldsrc = 2816; d.map = 1; break;
    case 1: d.s0 = KIN(5) + (size_t)l * 2816 * 1024; d.dst = wl + WO_D1; d.nrows = 1024; d.kdst = 2816; d.ksrc = 2816; d.ldsrc = 1024; break;
    case 2: d.s0 = KIN(7) + (size_t)l * 1024 * 9760; d.gain = KIN(6) + l * 1024; d.dst = wl + WO_IN; d.nrows = NINP; d.kdst = 1024; d.ksrc = 1024; d.ldsrc = 9760; d.map = 2; break;
    case 3: d.s0 = KIN(10) + (size_t)l * 384 * 768; d.gain = KIN(9) + l * 384; d.dst = wl + WO_UQ; d.nrows = 768; d.kdst = 384; d.ksrc = 384; d.ldsrc = 768; break;
    case 4: d.s0 = KIN(12) + (size_t)l * 128 * 1024; d.gain = KIN(11) + l * 128; d.dst = wl + WO_UKV; d.nrows = 1024; d.kdst = 256; d.ksrc = 128; d.ldsrc = 1024; break;
    case 5: d.s0 = KIN(13) + (size_t)l * 512 * 1024; d.dst = wl + WO_BA; d.nrows = 1024; d.kdst = 512; d.ksrc = 512; d.ldsrc = 1024; break;
    case 6: d.s0 = KIN(14) + (size_t)l * 512 * 1024; d.dst = wl + WO_BB; d.nrows = 1024; d.kdst = 512; d.ksrc = 512; d.ldsrc = 1024; break;
    case 7: d.s0 = KIN(15) + (size_t)l * 512 * 1024; d.dst = wl + WO_BC; d.nrows = 1024; d.kdst = 512; d.ksrc = 512; d.ldsrc = 1024; break;
    case 8: d.s0 = KIN(16) + (size_t)l * 1024 * 1024; d.dst = wl + WO_MO; d.nrows = 1024; d.kdst = 1024; d.ksrc = 1024; d.ldsrc = 1024; break;
    case 9: d.s0 = KIN(20) + (size_t)l * 1024 * 512; d.gain = KIN(18) + l * 1024; d.dst = wl + WO_XQ; d.nrows = 512; d.kdst = 1024; d.ksrc = 1024; d.ldsrc = 512; break;
    case 10: d.s0 = KIN(21) + (size_t)l * 1024 * 1024; d.gain = KIN(19) + l * 1024; d.dst = wl + WO_XKV; d.nrows = 1024; d.kdst = 1024; d.ksrc = 1024; d.ldsrc = 1024; break;
    case 11: d.s0 = KIN(22) + (size_t)l * 512 * 1024; d.dst = wl + WO_XO; d.nrows = 1024; d.kdst = 512; d.ksrc = 512; d.ldsrc = 1024; break;
    case 12: d.s0 = KIN(24) + (size_t)l * 1024 * 2816; d.s1 = KIN(25) + (size_t)l * 1024 * 2816; d.gain = KIN(23) + l * 1024; d.dst = wl + WO_GU2; d.nrows = 5632; d.kdst = 1024; d.ksrc = 1024; d.ldsrc = 2816; d.map = 1; break;
    default: d.s0 = KIN(26) + (size_t)l * 2816 * 1024; d.dst = wl + WO_D2; d.nrows = 1024; d.kdst = 2816; d.ksrc = 2816; d.ldsrc = 1024; break;
    }
    return d;
}

DI void rows_to_bf16(const float* src, bf16_t* dst, float* ss, int nrows, int gw, int nw) {
    const int lane = ltid() & 63;
    for (int r0 = gw; r0 < nrows; r0 += 2 * nw) {
        const int r1 = r0 + nw; const bool two = r1 < nrows;
        f32x4 va[4], vb[4];
#pragma unroll
        for (int i = 0; i < 4; ++i) { va[i] = *(const f32x4*)(src + (size_t)r0 * 1024 + i * 256 + lane * 4); vb[i] = two ? *(const f32x4*)(src + (size_t)r1 * 1024 + i * 256 + lane * 4) : (f32x4){0.f, 0.f, 0.f, 0.f}; }
        float qa = 0.f, qb = 0.f;
#pragma unroll
        for (int i = 0; i < 4; ++i) {
            qa += va[i][0] * va[i][0] + va[i][1] * va[i][1] + va[i][2] * va[i][2] + va[i][3] * va[i][3];
            qb += vb[i][0] * vb[i][0] + vb[i][1] * vb[i][1] + vb[i][2] * vb[i][2] + vb[i][3] * vb[i][3];
            u32x2 w; w.x = pk2(va[i][0], va[i][1]); w.y = pk2(va[i][2], va[i][3]);
            *(u32x2*)(dst + (size_t)r0 * 1024 + i * 256 + lane * 4) = w;
            if (two) { u32x2 w2; w2.x = pk2(vb[i][0], vb[i][1]); w2.y = pk2(vb[i][2], vb[i][3]); *(u32x2*)(dst + (size_t)r1 * 1024 + i * 256 + lane * 4) = w2; }
        }
        qa = wave_sum(qa); qb = wave_sum(qb);
        if (lane == 0) { ss[r0] = qa; if (two) ss[r1] = qb; }
    }
}


#define XB_TMO      128
#define XB_XCNT(j)  (256  + 64 * (j))
#define XB_XSUB(j)  (1280 + 64 * (j))
#define XB_XGEN(j)  (2304 + 64 * (j))
#define XB_TOP      3328
#define XB_TOPGEN   3392
#define XCD_BAR_WORDS 3456
#define XB_SPIN_CAP (1u << 20)
DI unsigned xb_ld(unsigned* p)              { return __hip_atomic_load(p, __ATOMIC_RELAXED, __HIP_MEMORY_SCOPE_AGENT); }
DI unsigned xb_add(unsigned* p, unsigned v) { return __hip_atomic_fetch_add(p, v, __ATOMIC_RELAXED, __HIP_MEMORY_SCOPE_AGENT); }
DI unsigned xb_xcc_id() { return (unsigned)__builtin_amdgcn_s_getreg((3 << 11) | 20) & 0xFu; }
#define XB_SPIN(cond, bar) do { unsigned _sp = 0; while (cond) { __builtin_amdgcn_s_sleep(1); \
    if ((++_sp & 255u) == 0u) { if (xb_ld(&(bar)[XB_TMO])) break; if (_sp > XB_SPIN_CAP) { atomicAdd(&(bar)[XB_TMO], 1u); break; } } } } while (0)
DI void xcd_barrier_complete(unsigned* bar, unsigned x, unsigned& nloc, unsigned& nx) {
    const unsigned G = gridDim.x * gridDim.y * gridDim.z;
    unsigned sum, cnt, mine, sp = 0u;
    for (;;) {
        sum = 0u; cnt = 0u; mine = 0u;
#pragma unroll
        for (unsigned j = 0; j < 16; ++j) { const unsigned c = xb_ld(&bar[XB_XCNT(j)]); sum += c; cnt += (c > 0u) ? 1u : 0u; mine = (j == x) ? c : mine; }
        if (sum == G) break;
        __builtin_amdgcn_s_sleep(1);
        if ((++sp & 255u) == 0u) { if (xb_ld(&bar[XB_TMO])) break; if (sp > XB_SPIN_CAP) { atomicAdd(&bar[XB_TMO], 1u); break; } }
    }
    nloc = mine > 0u ? mine : 1u; nx = cnt > 0u ? cnt : 1u;
}
DI void xcd_barrier(unsigned* bar, volatile LAS unsigned* st) {
    asm volatile("s_waitcnt vmcnt(0)" ::: "memory");
    __syncthreads();
    if (threadIdx.x == 0) {
        const unsigned x = xb_xcc_id();
        __builtin_amdgcn_s_waitcnt(0);
        unsigned nloc = st[0], nx = st[1];
        if (nloc == 0u) { xcd_barrier_complete(bar, x, nloc, nx); st[0] = nloc; st[1] = nx; }
        const unsigned old = xb_add(&bar[XB_XSUB(x)], 1u);
        const unsigned gen = old / nloc;
        if (old + 1u == (gen + 1u) * nloc) {
            __builtin_amdgcn_fence(__ATOMIC_RELEASE, "agent");
            asm volatile("s_waitcnt vmcnt(0)" ::: "memory");
            const unsigned og = xb_add(&bar[XB_TOP], 1u);
            const unsigned tg = og / nx;
            if (og + 1u == (tg + 1u) * nx) xb_add(&bar[XB_TOPGEN], 1u);
            else XB_SPIN(xb_ld(&bar[XB_TOPGEN]) == tg, bar);
            __builtin_amdgcn_fence(__ATOMIC_ACQUIRE, "agent");
            xb_add(&bar[XB_XGEN(x)], 1u);
            asm volatile("s_waitcnt vmcnt(0)" ::: "memory");
        } else {
            XB_SPIN(xb_ld(&bar[XB_XGEN(x)]) == gen, bar);
            __builtin_amdgcn_fence(__ATOMIC_ACQUIRE, "agent");
            asm volatile("s_waitcnt vmcnt(0)" ::: "memory");
        }
    }
    __syncthreads();
}

enum { OP_NONE = 0, OP_PROLOGUE, OP_SWIGLU, OP_SCALED0, OP_SCALED1, OP_SCALED2, OP_RESID, OP_GATE, OP_ATT_SBDIL, OP_ATT_MLA, OP_ATT_CROSS, OP_FINAL };
DI int op_kind(int ph, int op) {
    if (ph == 0) return op == 0 ? OP_PROLOGUE : OP_NONE;
    if (ph == 49) return op == 0 ? OP_FINAL : OP_NONE;
    const int k = (ph - 1) % 24;
    if (k == 0) return op == 0 ? OP_SWIGLU : OP_NONE;
    if (k == 1 || k == 18 || k == 21 || k == 23) return op == 0 ? OP_RESID : OP_NONE;
    if (k == 19) return op == 0 ? OP_SCALED0 : OP_NONE;
    if (k == 20) return op == 0 ? OP_ATT_CROSS : OP_NONE;
    if (k == 22) return op == 0 ? OP_SWIGLU : OP_NONE;
    const int sub = (k - 2) & 3;
    if (sub == 0) return op == 0 ? OP_SCALED1 : OP_NONE;
    if (sub == 1) return op == 0 ? OP_SCALED2 : (op == 1 ? OP_SCALED0 : OP_ATT_SBDIL);
    if (sub == 2) return op == 0 ? OP_ATT_MLA : OP_NONE;
    return op == 0 ? OP_GATE : ((op == 1 && k == 5) ? OP_SCALED0 : OP_NONE);
}

__global__ void __launch_bounds__(512, 2) mega(Params p) {
    extern __shared__ __attribute__((aligned(16))) unsigned char lds_raw[];
    LAS unsigned char* lds = (LAS unsigned char*)lds_raw;
    LAS int* s_item = (LAS int*)(lds + LDS_CTL);
    const kptr_t ka = (kptr_t)__builtin_amdgcn_kernarg_segment_ptr();
    volatile LAS unsigned* xb_st = (volatile LAS unsigned*)(lds + LDS_CTL + 16);
    if (threadIdx.x < 2) xb_st[threadIdx.x] = 0u;
    __syncthreads();
    const int ph_lo = *(const __attribute__((address_space(4))) int*)(ka + 240), ph_hi = *(const __attribute__((address_space(4))) int*)(ka + 244);
#define WSP(T_, off) ((T_*)(wsb + (off)))
#define QUEUE_BEGIN(n) for (;;) { __syncthreads(); if (tid == 0) *s_item = atomicAdd(WSP(int, WS_CTR) + ph + 50 * rep_, 1); __syncthreads(); const int item = *s_item; if (item >= (n)) break;
#define QUEUE_END }

#pragma unroll 1
    for (int ph = ph_lo; ph < ph_hi; ++ph) {
#pragma unroll 1
        for (int op = 0; op < 3; ++op) {
            const int kind = op_kind(ph, op);
            if (kind == OP_NONE) break;
            kptr_t kb = ka; asm volatile("" : "+s"(kb));
            unsigned char* wsb = KWS;
            const int G = gridDim.x, bid = blockIdx.x;
            const int l = (ph - 1) / 24, k = (ph - 1) % 24, ch = (k - 2) >> 2;
            const size_t row0 = (size_t)ch * TC;
            bf16_t* wl = WSP(bf16_t, WS_W) + (size_t)l * W_LAYER;
            float* ssz = WSP(float, WS_SSZ);
            unsigned char* R1 = wsb + WS_R1;
#pragma unroll 1
            for (int rep_ = 0; rep_ < ((kind == OP_ATT_SBDIL || kind == OP_ATT_MLA || kind == OP_ATT_CROSS) ? MK_REP_ATT : ((kind == OP_SWIGLU) ? MK_REP_GEMM : 1)); ++rep_)
            switch (kind) {
            case OP_PROLOGUE: {
#ifndef SKIP_OP_PROLOGUE
                const int tid = ltid();
                const int gw = bid * 8 + (tid >> 6), nw = G * 8;
                for (size_t i = (size_t)bid * 512 + tid; i < (size_t)NSSZ * T; i += (size_t)G * 512) ssz[i] = 0.f;
                if (bid == 0) { if (tid < 256) WSP(int, WS_CTR)[tid] = 0; for (int i = tid; i < XCD_BAR_WORDS; i += 512) WSP(unsigned, WS_BAR)[i] = 0u; }
                rows_to_bf16(KIN(0), WSP(bf16_t, WS_HB), WSP(float, WS_SS0), T, gw, nw);
                rows_to_bf16(KIN(1), WSP(bf16_t, WS_MEMB), WSP(float, WS_SSM), NB * MEML, gw, nw);
                float* rope = WSP(float, WS_ROPE);
                for (int i = bid * 512 + tid; i < SEQ * 16; i += G * 512) {
                    const int pos = i >> 4, fi = i & 15;
                    const float freq = exp2f(-(float)fi * (13.287712379549449f / 16.0f));
                    const float ang = (float)pos * freq;
                    const double rev = (double)ang * 0.15915494309189535;
                    const float fr = (float)(rev - rint(rev));
                    rope[2 * i] = __builtin_amdgcn_cosf(fr); rope[2 * i + 1] = __builtin_amdgcn_sinf(fr);
                }
                float* biasT = WSP(float, WS_BIAS);
                for (int i = bid * 512 + tid; i < 3 * 8 * 132; i += G * 512) {
                    const int g = i / (8 * 132), h = (i / 132) % 8, s = i % 132;
                    float v = 0.f;
                    if (s <= 128) {
                        const int r = (g == 0) ? 1 : (g == 1 ? 4 : 16), dist = s * r;
                        int bucket;
                        if (dist < 16) bucket = dist;
                        else { const float dd = (float)dist; const int large = 16 + (int)(logf(dd / 16.0f) / logf(128.0f) * 16.0f); bucket = large < 31 ? large : 31; }
                        v = KIN(17)[bucket * 24 + g * 8 + h] * LOG2E;
                    }
                    biasT[i] = v;
                }
                int goff_ = 0;
#pragma unroll 1
                for (int wi = 0; wi < 28; ++wi) goff_ = convert_weight(lds, wdesc(kb, WSP(bf16_t, WS_W) + (size_t)(wi / 14) * W_LAYER, wi / 14, wi % 14), G, bid, goff_);
#endif
            } break;
            case OP_SWIGLU: {
#ifndef SKIP_OP_SWIGLU
                const bool second = (k == 22);
                const float* ss_in = second ? (ssz + (size_t)(l * 4 + 2) * T) : (l == 0 ? WSP(float, WS_SS0) : ssz + (size_t)3 * T);
                pg8::Gemm g{WSP(bf16_t, WS_HB), wl + (second ? WO_GU2 : WO_GU1), 1024, 1024, T, 5632, 1024}; pg8::StaticOrder S; S.init(T, 5632, G, bid);
                pg8::EpiSwiglu E{(bf16_t*)(R1 + R_ACT), FF, ss_in}; pg8::gemm_phase(lds, g, S, E);
#endif
            } break;
            case OP_SCALED0: {
#ifndef SKIP_OP_SCALED0
                pg8::Gemm g; pg8::StaticOrder S; pg8::EpiScaled<0> E; E.ss_cq = nullptr; E.ss_ckv = nullptr; E.rope = nullptr;
                if (k == 5) {
                    g = pg8::Gemm{WSP(bf16_t, WS_MEMB), wl + WO_XKV, 1024, 1024, 2048, 1024, 1024}; S.init(2048, 1024, G, (bid + G - 128) % G);
                    E.O = WSP(bf16_t, WS_KVX) + (size_t)l * 2048 * 1024; E.ldc = 1024; E.ss = WSP(float, WS_SSM); E.inv_dim = 1.0f / 1024.0f;
                } else if (k == 19) {
                    g = pg8::Gemm{WSP(bf16_t, WS_HB), wl + WO_XQ, 1024, 1024, T, 512, 1024}; S.init(T, 512, G, bid);
                    E.O = (bf16_t*)(R1 + R_QX); E.ldc = 512; E.ss = ssz + (size_t)(l * 4 + 1) * T; E.inv_dim = 1.0f / 1024.0f;
                } else {
                    g = pg8::Gemm{(bf16_t*)(R1 + R_P) + C_CKV, wl + WO_UKV, NINP, 256, TC, 1024, 256}; S.init(TC, 1024, G, (bid + G - 96) % G);
                    E.O = (bf16_t*)(R1 + R_KVM); E.ldc = 1024; E.ss = ssz + (size_t)(9 + l * 2) * T + row0; E.inv_dim = 1.0f / 128.0f;
                }
                pg8::gemm_phase(lds, g, S, E);
#endif
            } break;
            case OP_SCALED1: {
#ifndef SKIP_OP_SCALED1
                pg8::Gemm g{WSP(bf16_t, WS_HB) + row0 * 1024, wl + WO_IN, 1024, 1024, TC, NINP, 1024}; pg8::StaticOrder S; S.init(TC, NINP, G, bid);
                pg8::EpiScaled<1> E{(bf16_t*)(R1 + R_P), NINP, ssz + (size_t)(l * 4 + 0) * T + row0, 1.0f / 1024.0f, ssz + (size_t)(8 + l * 2) * T + row0, ssz + (size_t)(9 + l * 2) * T + row0, WSP(float, WS_ROPE)};
                pg8::gemm_phase(lds, g, S, E);
#endif
            } break;
            case OP_SCALED2: {
#ifndef SKIP_OP_SCALED2
                pg8::Gemm g{(bf16_t*)(R1 + R_P) + C_CQ, wl + WO_UQ, NINP, 384, TC, 768, 384}; pg8::StaticOrder S; S.init(TC, 768, G, bid);
                pg8::EpiScaled<2> E{(bf16_t*)(R1 + R_QM), 768, ssz + (size_t)(8 + l * 2) * T + row0, 1.0f / 384.0f, nullptr, nullptr, WSP(float, WS_ROPE)};
                pg8::gemm_phase(lds, g, S, E);
#endif
            } break;
            case OP_RESID: {
#ifndef SKIP_OP_RESID
                const bool f1 = (k == 1), mo = (k == 18), xo = (k == 21);
                const size_t aoffb = mo ? R_MB : (xo ? R_OX : R_ACT);
                const size_t woff = f1 ? WO_D1 : (mo ? WO_MO : (xo ? WO_XO : WO_D2));
                const int kk = mo ? 1024 : (xo ? 512 : FF);
                const int ssi = l * 4 + (f1 ? 0 : (mo ? 1 : (xo ? 2 : 3)));
                float* const hout_ = KOUT;
                const float* const x_ = KIN(0);
                const float* const hin_ = (f1 && l == 0) ? x_ : (const float*)hout_;
                pg8::Gemm g{(bf16_t*)(R1 + aoffb), wl + woff, kk, kk, T, 1024, kk}; pg8::StaticOrder S; S.init(T, 1024, G, bid);
                pg8::EpiResid E{hin_, hout_, (l == 1 && k == 23) ? (bf16_t*)nullptr : WSP(bf16_t, WS_HB), ssz + (size_t)ssi * T, (mo || xo) ? 1.0f : 0.5f};
                pg8::gemm_phase(lds, g, S, E);
#endif
            } break;
            case OP_GATE: {
#ifndef SKIP_OP_GATE
                pg8::Gemm g{(bf16_t*)(R1 + R_OA), wl + WO_BA, 512, 512, 3 * TC, 3072, 512}; pg8::StaticOrder S; S.init(2 * TC, 1024, G, bid); S.passes(3, TC / 128, 4);
                pg8::EpiGate E{(bf16_t*)(R1 + R_P) + C_GATE, NINP, KIN(8) + (size_t)(l * 3) * 1024, (float*)(R1 + R_M32), (bf16_t*)(R1 + R_MB) + row0 * 1024};
                pg8::gemm_phase<pg8::EpiGate, true>(lds, g, S, E);
#endif
            } break;
            case OP_ATT_SBDIL: {
#ifndef SKIP_OP_ATT_SBDIL
                const int tid = ltid();
                bf16_t* P = (bf16_t*)(R1 + R_P);
                for (int item = bid; item < 768; item += G) {
                    {
                        const int j = item, g = j >> 8, bl = (j >> 7) & 1, h = (j >> 4) & 7, sub = j & 15;
                        const int r = (g == 0) ? 1 : (g == 1 ? 4 : 16), cls = sub % r, qt = sub / r;
                        const bf16_t* base = P + C_DIL + g * 1536 + h * 64;
                        AttnArgs a; a.Q = base; a.ldq = NINP; a.K = base + 512; a.ldk = NINP; a.K2 = nullptr; a.ldk2 = 0;
                        a.V = base + 1024; a.ldv = NINP; a.O = (bf16_t*)(R1 + R_OG) + (size_t)g * TC * 512 + h * 64; a.ldo = 512;
                        a.lse = (float*)(R1 + R_LSE) + (size_t)g * TC * 8 + h; a.ldl = 8;
                        a.q0 = qt * 256; a.tstride = r; a.toff = bl * SEQ + cls; a.nk = 0; a.c2 = 0.125f * LOG2E; a.biasg = WSP(float, WS_BIAS) + (g * 8 + h) * 132;
                        attn_dil_unit(lds, a);
                    }
                }
#endif
            } break;
            case OP_ATT_MLA: {
#ifndef SKIP_OP_ATT_MLA
                const int tid = ltid();
                QUEUE_BEGIN(512 + 256)
                    if (item >= 256 && item < 512) {
                        bf16_t* P = (bf16_t*)(R1 + R_P);
                        const int qt = 15 - ((item - 256) >> 4), bl = (item >> 3) & 1, h = item & 7;
                        AttnArgs a; a.Q = P + C_SBQ + h * 64; a.ldq = NINP; a.K = P + C_SBK + h * 64; a.ldk = NINP; a.K2 = nullptr; a.ldk2 = 0;
                        a.V = P + C_SBV + h * 64; a.ldv = NINP; a.O = (bf16_t*)(R1 + R_OA) + h * 64; a.ldo = 512; a.lse = nullptr; a.ldl = 0;
                        a.q0 = qt * 256; a.tstride = 1; a.toff = bl * SEQ; a.nk = 0; a.c2 = 0.125f * LOG2E; a.biasg = nullptr;
                        attn_unit<2>(lds, a);
                    } else if (item < 256) {
                        const int qt = 15 - (item >> 4), bl = (item >> 3) & 1, h = item & 7;
                        bf16_t* kvm = (bf16_t*)(R1 + R_KVM);
                        AttnArgs a; a.Q = (bf16_t*)(R1 + R_QM) + h * 96; a.ldq = 768; a.K = kvm + h * 128; a.ldk = 1024; a.K2 = (bf16_t*)(R1 + R_P) + C_KR; a.ldk2 = NINP;
                        a.V = kvm + h * 128 + 64; a.ldv = 1024; a.O = (bf16_t*)(R1 + R_OA) + (size_t)TC * 512 + h * 64; a.ldo = 512; a.lse = nullptr; a.ldl = 0;
                        a.q0 = qt * 256; a.tstride = 1; a.toff = bl * SEQ; a.nk = 0; a.c2 = 0.10206207261596577f * LOG2E; a.biasg = nullptr;
                        attn_unit<1>(lds, a);
                    } else {
                        const int t0 = (item - 512) * 32;
                        bf16_t* oc = (bf16_t*)(R1 + R_OA) + (size_t)2 * TC * 512;
                        const bf16_t* og = (const bf16_t*)(R1 + R_OG);
                        const float* lse = (const float*)(R1 + R_LSE);
#pragma unroll
                        for (int ps = 0; ps < 4; ++ps) {
                            const int tok = t0 + ps * 8 + (tid >> 6), c8 = (tid & 63) * 8, h = c8 >> 6;
                            const float l0 = lse[(size_t)tok * 8 + h], l1 = lse[(size_t)(TC + tok) * 8 + h], l2 = lse[(size_t)(2 * TC + tok) * 8 + h];
                            const float mx = fmaxf(l0, fmaxf(l1, l2));
                            float w0 = ex2(l0 - mx), w1 = ex2(l1 - mx), w2 = ex2(l2 - mx);
                            const float is = 1.0f / (w0 + w1 + w2); w0 *= is; w1 *= is; w2 *= is;
                            const u32x4 a0 = *(const u32x4*)(og + (size_t)tok * 512 + c8), a1 = *(const u32x4*)(og + (size_t)(TC + tok) * 512 + c8), a2 = *(const u32x4*)(og + (size_t)(2 * TC + tok) * 512 + c8);
                            u32x4 w;
                            w.x = pk2(w0 * bflo(a0.x) + w1 * bflo(a1.x) + w2 * bflo(a2.x), w0 * bfhi(a0.x) + w1 * bfhi(a1.x) + w2 * bfhi(a2.x));
                            w.y = pk2(w0 * bflo(a0.y) + w1 * bflo(a1.y) + w2 * bflo(a2.y), w0 * bfhi(a0.y) + w1 * bfhi(a1.y) + w2 * bfhi(a2.y));
                            w.z = pk2(w0 * bflo(a0.z) + w1 * bflo(a1.z) + w2 * bflo(a2.z), w0 * bfhi(a0.z) + w1 * bfhi(a1.z) + w2 * bfhi(a2.z));
                            w.w = pk2(w0 * bflo(a0.w) + w1 * bflo(a1.w) + w2 * bflo(a2.w), w0 * bfhi(a0.w) + w1 * bfhi(a1.w) + w2 * bfhi(a2.w));
                            *(u32x4*)(oc + (size_t)tok * 512 + c8) = w;
                        }
                    }
                QUEUE_END
#endif
            } break;
            case OP_ATT_CROSS: {
#ifndef SKIP_OP_ATT_CROSS
                const int tid = ltid();
                const bf16_t* kvxl = WSP(bf16_t, WS_KVX) + (size_t)l * 2048 * 1024;
                for (int item = bid; item < 512; item += G) {
                    const int b = item >> 6, h = (item >> 4) & 3, qt = item & 15;
                    AttnArgs a; a.Q = (bf16_t*)(R1 + R_QX) + (size_t)b * SEQ * 512 + h * 128; a.ldq = 512;
                    a.K = kvxl + (size_t)b * MEML * 1024 + h * 128; a.ldk = 1024; a.K2 = nullptr; a.ldk2 = 0;
                    a.V = kvxl + (size_t)b * MEML * 1024 + 512 + h * 128; a.ldv = 1024;
                    a.O = (bf16_t*)(R1 + R_OX) + (size_t)b * SEQ * 512 + h * 128; a.ldo = 512; a.lse = nullptr; a.ldl = 0;
                    a.q0 = qt * 256; a.tstride = 1; a.toff = 0; a.nk = MEML; a.c2 = 0.08838834764831845f * LOG2E; a.biasg = nullptr;
                    attn_unit<0>(lds, a);
                }
#endif
            } break;
            default: {
                const int tid = ltid();
                const float* ssf = ssz + (size_t)7 * T;
                const float* gf = KIN(27);
                float* hres = KOUT;
                const int lane = tid & 63;
                for (int r = bid * 8 + (tid >> 6); r < T; r += G * 8) {
                    const float rs = __builtin_amdgcn_rsqf(ssf[r] * (1.0f / 1024.0f) + EPS);
#pragma unroll
                    for (int i = 0; i < 4; ++i) {
                        const size_t off = (size_t)r * 1024 + i * 256 + lane * 4;
                        f32x4 v = *(const f32x4*)(hres + off); const f32x4 gg = *(const f32x4*)(gf + i * 256 + lane * 4);
                        v = v * rs * gg;
                        *(f32x4*)(hres + off) = v;
                    }
                }
            } break;
            }
        }
        if (ph + 1 < ph_hi) {
            kptr_t kb = ka; asm volatile("" : "+s"(kb));
            unsigned* bar = (unsigned*)(KWS + WS_BAR);
            if (ph == 0) {
                cg::this_grid().sync();
                if (threadIdx.x == 0) (void)xb_add(&bar[XB_XCNT(xb_xcc_id())], 1u);
            } else {
                for (int rs_ = 0; rs_ < MK_REP_SYNC; ++rs_) xcd_barrier(bar, xb_st);
            }
        }
    }
}

constexpr int N_PHASES = 50;

extern "C" void kernel_launch(void* const* d_in, const int* in_sizes, int n_in, void* d_out, int out_size, void* d_ws, size_t ws_size, hipStream_t stream) {
    static int grid = 0;
    if (grid == 0) {
        if (n_in != 28 || out_size != T * DM || ws_size < WS_END) { fprintf(stderr, "kernel_launch: unexpected shapes (n_in %d out %d ws %zu need %zu)\n", n_in, out_size, ws_size, (size_t)WS_END); grid = -1; return; }
        int dev = 0, cus = 0, per_cu = 0;
        hipGetDevice(&dev);
        hipDeviceGetAttribute(&cus, hipDeviceAttributeMultiprocessorCount, dev);
        if (hipFuncSetAttribute((const void*)mega, hipFuncAttributeMaxDynamicSharedMemorySize, LDS_BYTES) != hipSuccess) { fprintf(stderr, "kernel_launch: hipFuncSetAttribute failed\n"); grid = -1; return; }
        if (hipOccupancyMaxActiveBlocksPerMultiprocessor(&per_cu, (const void*)mega, 512, LDS_BYTES) != hipSuccess || per_cu < 1) { fprintf(stderr, "kernel_launch: occupancy query says %d\n", per_cu); per_cu = 1; }
        (void)hipGetLastError();
        grid = cus * 1;
        fprintf(stderr, "kernel_launch: grid %d (cus %d, per_cu %d)\n", grid, cus, per_cu);
    }
    if (grid < 0) return;
    Params p{};
    for (int i = 0; i < 28; ++i) p.in[i] = (const float*)d_in[i];
    p.out = (float*)d_out; p.ws = (unsigned char*)d_ws;
#if MK_PER_PHASE
    for (int k = MK_MINPH; k < MK_MAXPH; ++k) { p.ph_lo = k; p.ph_hi = k + 1; hipLaunchKernelGGL(mega, dim3(grid), dim3(512), LDS_BYTES, stream, p); }
#else
    p.ph_lo = 0; p.ph_hi = MK_MAXPH;
    void* args[] = {&p};
    hipError_t e = hipLaunchCooperativeKernel((const void*)mega, dim3(grid), dim3(512), args, LDS_BYTES, stream);
    if (e != hipSuccess) fprintf(stderr, "kernel_launch: cooperative launch failed: %s (grid %d)\n", hipGetErrorString(e), grid);
#endif
}
```

```cpp
#include <hip/hip_runtime.h>
#include <hip/hip_cooperative_groups.h>
#include <cstdio>
#include <cstdint>
namespace cg = cooperative_groups;

#ifndef MK_REP_SYNC
#define MK_REP_SYNC 1
#endif
#ifndef MK_REP_ATT
#define MK_REP_ATT 1
#endif
#ifndef MK_REP_GEMM
#define MK_REP_GEMM 1
#endif
#ifndef MK_MINPH
#define MK_MINPH 0
#endif
#ifndef MK_MAXPH
#define MK_MAXPH 50
#endif
#ifndef MK_PER_PHASE
#define MK_PER_PHASE 0
#endif

#define LAS __attribute__((address_space(3)))
#define DI __device__ __forceinline__
typedef unsigned short bf16_t;
typedef short bf16x8 __attribute__((ext_vector_type(8)));
typedef short s16x4 __attribute__((ext_vector_type(4)));
typedef float f32x4 __attribute__((ext_vector_type(4)));
typedef float f32x16 __attribute__((ext_vector_type(16)));
typedef unsigned u32x4 __attribute__((ext_vector_type(4)));
typedef unsigned u32x2 __attribute__((ext_vector_type(2)));
typedef float f32x2_t __attribute__((ext_vector_type(2)));
typedef __bf16 bf16x2_t __attribute__((ext_vector_type(2)));

DI unsigned pk2(float lo, float hi) { f32x2_t v = {lo, hi}; bf16x2_t b = __builtin_convertvector(v, bf16x2_t); return __builtin_bit_cast(unsigned, b); }
DI float bflo(unsigned u) { return __uint_as_float(u << 16); }
DI float bfhi(unsigned u) { return __uint_as_float(u & 0xffff0000u); }
DI float ex2(float x) { return __builtin_amdgcn_exp2f(x); }
DI float lg2(float x) { return __builtin_amdgcn_logf(x); }
DI float sigmoidf_(float x) { return __builtin_amdgcn_rcpf(1.0f + __builtin_amdgcn_exp2f(x * -1.4426950408889634f)); }
DI float max3f(float a, float b, float c) { float r; asm("v_max3_f32 %0, %1, %2, %3" : "=v"(r) : "v"(a), "v"(b), "v"(c)); return r; }
DI int ltid() { int t = threadIdx.x; asm volatile("" : "+v"(t)); return t; }

constexpr int T = 32768, DM = 1024, SEQ = 4096, NB = 8, FF = 2816, MEML = 256;
constexpr int TC = 8192, NCH = 4, BPC = 2;
constexpr int NINP = 9984;
constexpr int C_SBQ = 0, C_SBK = 512, C_SBV = 1024, C_CQ = 1536, C_CKV = 1920, C_KR = 2048, C_DIL = 2304, C_GATE = 6912;
constexpr float EPS = 1e-6f, LOG2E = 1.4426950408889634f;

constexpr size_t al(size_t x) { return (x + 255) & ~(size_t)255; }
constexpr size_t WS_CTR = 0;
constexpr size_t WS_BAR = 1024;
constexpr size_t WS_SSZ = 16384;
constexpr int    NSSZ = 12;
constexpr size_t WS_SS0 = WS_SSZ + (size_t)NSSZ * T * 4;
constexpr size_t WS_SSM = WS_SS0 + (size_t)T * 4;
constexpr size_t WS_ROPE = WS_SSM + 2048 * 4;
constexpr size_t WS_BIAS = WS_ROPE + (size_t)4096 * 16 * 8;
constexpr size_t WS_MEMB = al(WS_BIAS + 3 * 8 * 132 * 4);
constexpr size_t WS_KVX = WS_MEMB + (size_t)2048 * 1024 * 2;
constexpr size_t WS_HB = WS_KVX + (size_t)2 * 2048 * 1024 * 2;
constexpr size_t WS_W = WS_HB + (size_t)T * 1024 * 2;
constexpr size_t WO_GU1 = 0;
constexpr size_t WO_D1 = WO_GU1 + (size_t)5632 * 1024;
constexpr size_t WO_IN = WO_D1 + (size_t)1024 * 2816;
constexpr size_t WO_UQ = WO_IN + (size_t)NINP * 1024;
constexpr size_t WO_UKV = WO_UQ + (size_t)768 * 384;
constexpr size_t WO_BA = WO_UKV + (size_t)1024 * 256;
constexpr size_t WO_BB = WO_BA + (size_t)1024 * 512;
constexpr size_t WO_BC = WO_BB + (size_t)1024 * 512;
constexpr size_t WO_MO = WO_BC + (size_t)1024 * 512;
constexpr size_t WO_XQ = WO_MO + (size_t)1024 * 1024;
constexpr size_t WO_XKV = WO_XQ + (size_t)512 * 1024;
constexpr size_t WO_XO = WO_XKV + (size_t)1024 * 1024;
constexpr size_t WO_GU2 = WO_XO + (size_t)1024 * 512;
constexpr size_t WO_D2 = WO_GU2 + (size_t)5632 * 1024;
constexpr size_t W_LAYER = WO_D2 + (size_t)1024 * 2816;
constexpr size_t WS_R1 = WS_W + 2 * W_LAYER * 2;
constexpr size_t R_P = 0;
constexpr size_t R_QM = R_P + (size_t)TC * NINP * 2;
constexpr size_t R_KVM = R_QM + (size_t)TC * 768 * 2;
constexpr size_t R_OG = R_KVM + (size_t)TC * 1024 * 2;
constexpr size_t R_M32 = R_QM;
constexpr size_t R_OA = R_OG + (size_t)3 * TC * 512 * 2;
constexpr size_t R_LSE = R_OA + (size_t)3 * TC * 512 * 2;
constexpr size_t R_MB = R_LSE + (size_t)3 * TC * 8 * 4;
constexpr size_t R_END = R_MB + (size_t)T * 1024 * 2;
constexpr size_t R_ACT = 0;
constexpr size_t R_QX = 0;
constexpr size_t R_OX = (size_t)T * 512 * 2;
static_assert((size_t)TC * 1024 * 4 <= R_OA - R_QM, "m32 alias");
static_assert((size_t)T * FF * 2 <= R_END, "act fits");
constexpr size_t WS_END = WS_R1 + R_END;
static_assert(WS_END <= (size_t)512 * 1024 * 1024, "workspace");

constexpr int LDS_BYTES = 147456;
constexpr int LDS_CTL = 131072;

namespace pg8 {
constexpr int BM = 256, BK = 64, HALF = 128, HTB = HALF * BK * 2, STAGE_BYTES = 8 * HTB, NXCD = 8, WGM = 8;
DI int lds_byte(int r, int c) { const int st = (r >> 4) * 2 + (c >> 5), rr = r & 15, cc = c & 31, ob = rr * 64 + cc * 2; return st * 1024 + (ob ^ (((ob >> 9) & 1) << 5)); }
DI void stage_rc(int b, int& R, int& C) { const int st = b / 1024, sb = b % 1024, swz = sb ^ (((sb >> 9) & 1) << 5); R = (st >> 1) * 16 + swz / 64; C = (st & 1) * 32 + (swz % 64) / 2; }
DI int perm32(int rho) { const int n = rho >> 4, i = rho & 15; return 8 * (i >> 2) + 4 * n + (i & 3); }
struct Unit { int pm, pn; };
struct Gemm { const bf16_t* A; const bf16_t* Bt; int lda, ldb, M, N, K; };
struct StaticOrder {
    int nM, nN, nwg, G, c, npass, pms, pns;
    DI void init(int M, int N, int G_, int c_) { nM = M / BM; nN = N / BM; nwg = nM * nN; G = G_; c = c_; npass = 1; pms = 0; pns = 0; }
    DI void passes(int np, int pms_, int pns_) { npass = np; pms = pms_; pns = pns_; }
    DI bool next(int i_, Unit& u) const {
        const int i = (npass == 1) ? i_ : i_ / npass, b = i_ - i * npass;
        const long L = (long)i * G + c; if (L >= nwg) return false;
        int wgid = (int)L; { const int q = nwg / NXCD, r = nwg % NXCD, xcd = wgid % NXCD, off = wgid / NXCD; wgid = (xcd < r ? xcd * (q + 1) : r * (q + 1) + (xcd - r) * q) + off; }
        const int nig = WGM * nN, gid = wgid / nig, fm = gid * WGM, gsz = (nM - fm) < WGM ? (nM - fm) : WGM;
        u.pm = fm + ((wgid % nig) % gsz) + b * pms; u.pn = (wgid % nig) / gsz + b * pns; return true;
    }
};


template <class Epi, bool HALFM = false>
DI void gemm_phase(LAS unsigned char* lds, const Gemm g, const StaticOrder& S, const Epi& E) {
    const int tid = ltid(), wid = __builtin_amdgcn_readfirstlane(tid >> 6), lane = tid & 63, wr = wid >> 2, wc = wid & 3, fr = lane & 15, fq = lane >> 4;
    const int K = g.K, nt = K / BK;
    unsigned voffA[2], voffB[2];
#pragma unroll
    for (int i = 0; i < 2; ++i) { int R, C; stage_rc(tid * 16 + i * 8192, R, C); const int Rb = (R & ~31) + perm32(R & 31);
        voffA[i] = (unsigned)(R * g.lda + C) * 2u; voffB[i] = (unsigned)(Rb * g.ldb + C) * 2u; }
    const size_t kstep = (size_t)(BK * 2);
    const size_t hstepA = (size_t)HALF * g.lda * 2, hstepB = (size_t)HALF * g.ldb * 2;
    const size_t tstepA = HALFM ? hstepA : 2 * hstepA, tstepB = 2 * hstepB;
    const unsigned ldsw = (unsigned)wid * 1024u;
    const int aoff = lds_byte(wr * 64 + fr, fq * 8), boff = lds_byte(wc * 32 + fr, fq * 8);
#define PG8_SA(b, h) (((b) * 2 + (h)) * HTB)
#define PG8_SB(b, h) ((4 + (b) * 2 + (h)) * HTB)
#define PG8_STAGE(bufoff, gbase, voff) do { _Pragma("unroll") for (int _i = 0; _i < 2; ++_i) \
        __builtin_amdgcn_global_load_lds((const unsigned*)((const char*)(gbase) + (voff)[_i]), (LAS unsigned*)(lds + (bufoff) + ldsw + _i * 8192), 16, 0, 0); } while (0)
#define PG8_LDA(dst, b, h) do { _Pragma("unroll") for (int m = 0; m < 4; ++m) _Pragma("unroll") for (int k = 0; k < 2; ++k) dst[m][k] = *(const LAS bf16x8*)(lds + PG8_SA(b, h) + aoff + m * 2048 + k * 1024); } while (0)
#define PG8_LDB(dst, b, h) do { _Pragma("unroll") for (int n = 0; n < 2; ++n) _Pragma("unroll") for (int k = 0; k < 2; ++k) dst[n][k] = *(const LAS bf16x8*)(lds + PG8_SB(b, h) + boff + n * 2048 + k * 1024); } while (0)
#define PG8_MMA(ai, bj, At, Bt) do { __builtin_amdgcn_s_setprio(1); _Pragma("unroll") for (int m = 0; m < 4; ++m) _Pragma("unroll") for (int n = 0; n < 2; ++n) _Pragma("unroll") for (int k = 0; k < 2; ++k) \
        acc[ai][bj][m][n] = __builtin_amdgcn_mfma_f32_16x16x32_bf16(Bt[n][k], At[m][k], acc[ai][bj][m][n], 0, 0, 0); __builtin_amdgcn_s_setprio(0); } while (0)
#define PG8_WAIT_V(n) asm volatile("s_waitcnt vmcnt(" #n ")" ::: "memory")
#define PG8_WAIT_L(n) asm volatile("s_waitcnt lgkmcnt(" #n ")" ::: "memory")
#define PG8_BAR __builtin_amdgcn_s_barrier()
#define PG8_SCHED __builtin_amdgcn_sched_barrier(0)
    Unit cur, nxt; int ui = 0;
    if (!S.next(0, cur)) return;
    f32x4 acc[2][2][4][2];
#pragma unroll
    for (int a = 0; a < 2; ++a)
#pragma unroll
        for (int b = 0; b < 2; ++b)
#pragma unroll
            for (int m = 0; m < 4; ++m)
#pragma unroll
                for (int n = 0; n < 2; ++n) acc[a][b][m][n] = (f32x4){0.f, 0.f, 0.f, 0.f};
    bf16x8 At[4][2], B0[2][2], B1[2][2];
    const char* cA = (const char*)g.A + (size_t)cur.pm * tstepA; const char* cB = (const char*)g.Bt + (size_t)cur.pn * tstepB;
    PG8_STAGE(PG8_SB(0, 0), cB, voffB); PG8_STAGE(PG8_SB(0, 1), cB + hstepB, voffB); PG8_STAGE(PG8_SA(0, 0), cA, voffA); PG8_STAGE(PG8_SA(0, 1), cA + hstepA, voffA);
    if (wr == 1) PG8_BAR;
    PG8_WAIT_V(2); PG8_BAR;
    PG8_STAGE(PG8_SB(1, 0), cB + kstep, voffB); PG8_STAGE(PG8_SA(1, 0), cA + kstep, voffA); PG8_STAGE(PG8_SB(1, 1), cB + hstepB + kstep, voffB);
    PG8_WAIT_V(6); PG8_BAR;
    for (;;) {
        const bool has_next = S.next(ui + 1, nxt);
        const char* nA = has_next ? (const char*)g.A + (size_t)nxt.pm * tstepA : cA; const char* nB = has_next ? (const char*)g.Bt + (size_t)nxt.pn * tstepB : cB;
#pragma unroll 1
        for (int t = 0; t < nt; t += 2) {
            const bool last = (t == nt - 2);
            const char* a1 = cA + (size_t)(t + 1) * kstep;
            const char* a2 = last ? nA : cA + (size_t)(t + 2) * kstep; const char* b2 = last ? nB : cB + (size_t)(t + 2) * kstep;
            const char* a3 = a2 + kstep; const char* b3 = b2 + kstep;
            PG8_LDB(B0, 0, 0); PG8_LDB(B1, 0, 1); PG8_SCHED; PG8_LDA(At, 0, 0); PG8_STAGE(PG8_SA(1, 1), a1 + hstepA, voffA);
            PG8_WAIT_V(8); PG8_WAIT_L(0); PG8_BAR; PG8_MMA(0, 0, At, B0); PG8_MMA(0, 1, At, B1); PG8_BAR; PG8_SCHED;
            if constexpr (!HALFM) PG8_LDA(At, 0, 1);
            PG8_STAGE(PG8_SB(0, 0), b2, voffB); PG8_STAGE(PG8_SB(0, 1), b2 + hstepB, voffB); PG8_STAGE(PG8_SA(0, 0), a2, voffA);
            PG8_WAIT_V(8); PG8_WAIT_L(0); PG8_BAR; if constexpr (!HALFM) { PG8_MMA(1, 0, At, B0); PG8_MMA(1, 1, At, B1); } PG8_BAR; PG8_SCHED;
            PG8_LDB(B0, 1, 0); PG8_LDB(B1, 1, 1); PG8_SCHED; PG8_LDA(At, 1, 0); PG8_STAGE(PG8_SA(0, 1), a2 + hstepA, voffA);
            PG8_WAIT_V(8); PG8_WAIT_L(0); PG8_BAR; PG8_MMA(0, 0, At, B0); PG8_MMA(0, 1, At, B1); PG8_BAR; PG8_SCHED;
            if constexpr (!HALFM) PG8_LDA(At, 1, 1);
            PG8_STAGE(PG8_SB(1, 0), b3, voffB); PG8_STAGE(PG8_SB(1, 1), b3 + hstepB, voffB); PG8_STAGE(PG8_SA(1, 0), a3, voffA);
            PG8_WAIT_V(8); PG8_WAIT_L(0); PG8_BAR; if constexpr (!HALFM) { PG8_MMA(1, 0, At, B0); PG8_MMA(1, 1, At, B1); } PG8_BAR; PG8_SCHED;
        }
        if (wr == 0) PG8_BAR;
        { const int l2 = ltid() & 63; E(acc, cur, wr, wc, l2 & 15, l2 >> 4); }
        if (!has_next) break;
#pragma unroll
        for (int a = 0; a < (HALFM ? 1 : 2); ++a)
#pragma unroll
            for (int b = 0; b < 2; ++b)
#pragma unroll
                for (int m = 0; m < 4; ++m)
#pragma unroll
                    for (int n = 0; n < 2; ++n) acc[a][b][m][n] = (f32x4){0.f, 0.f, 0.f, 0.f};
        cur = nxt; cA = nA; cB = nB; ++ui;
        if (wr == 1) PG8_BAR;
    }
    PG8_WAIT_V(0);
    PG8_BAR;
#undef PG8_SA
#undef PG8_SB
#undef PG8_STAGE
#undef PG8_LDA
#undef PG8_LDB
#undef PG8_MMA
#undef PG8_WAIT_V
#undef PG8_WAIT_L
#undef PG8_BAR
#undef PG8_SCHED
}

template <int MODE> struct EpiScaled {
    bf16_t* O; int ldc; const float* ss; float inv_dim; float* ss_cq; float* ss_ckv; const float* rope;
    DI void operator()(const f32x4 (&acc)[2][2][4][2], const Unit& u, int wr, int wc, int fr, int fq) const {
        const int row0 = u.pm * BM + wr * 64 + fr, col0 = u.pn * BM + wc * 32 + 8 * fq;
        float ssv[2][4];
#pragma unroll
        for (int ai = 0; ai < 2; ++ai)
#pragma unroll
            for (int m = 0; m < 4; ++m) ssv[ai][m] = ss ? ss[row0 + ai * HALF + m * 16] : 0.f;
#pragma unroll
        for (int ai = 0; ai < 2; ++ai)
#pragma unroll
            for (int m = 0; m < 4; ++m) {
                const int r = row0 + ai * HALF + m * 16;
                const float rs = ss ? __builtin_amdgcn_rsqf(ssv[ai][m] * inv_dim + EPS) : 1.f;
#pragma unroll
                for (int bj = 0; bj < 2; ++bj) {
                    float v[8];
#pragma unroll
                    for (int j = 0; j < 4; ++j) { v[j] = acc[ai][bj][m][0][j] * rs; v[4 + j] = acc[ai][bj][m][1][j] * rs; }
                    bool do_rope = false;
                    if (MODE == 1) {
                        const bool cq = (u.pn == 6) || (u.pn == 7 && bj == 0), ckv = (u.pn == 7 && bj == 1);
                        if (cq || ckv) {
                            float q = 0.f;
#pragma unroll
                            for (int j = 0; j < 8; ++j) q += v[j] * v[j];
                            q += __shfl_xor(q, 16); q += __shfl_xor(q, 32);
                            if (fq == 0) unsafeAtomicAdd((cq ? ss_cq : ss_ckv) + r, q);
                        }
                        do_rope = (u.pn == 8 && bj == 0 && wc == 0);
                    }
                    if (MODE == 2) { const int g32 = (u.pn * BM + bj * HALF + wc * 32) >> 5; do_rope = (g32 % 3) == 2; }
                    if (MODE != 0 && do_rope) {
                        const int pos = r & (SEQ - 1);
                        const f32x4* cs = (const f32x4*)(rope + ((size_t)pos * 16 + 8 * (fq & 1)) * 2);
#pragma unroll
                        for (int jj = 0; jj < 4; ++jj) {
                            const f32x4 c4 = cs[jj];
                            const float p0 = __shfl_xor(v[2 * jj], 32), p1 = __shfl_xor(v[2 * jj + 1], 32);
                            if (fq < 2) { v[2 * jj] = v[2 * jj] * c4[0] - p0 * c4[1]; v[2 * jj + 1] = v[2 * jj + 1] * c4[2] - p1 * c4[3]; }
                            else        { v[2 * jj] = p0 * c4[1] + v[2 * jj] * c4[0]; v[2 * jj + 1] = p1 * c4[3] + v[2 * jj + 1] * c4[2]; }
                        }
                    }
                    u32x4 w; w.x = pk2(v[0], v[1]); w.y = pk2(v[2], v[3]); w.z = pk2(v[4], v[5]); w.w = pk2(v[6], v[7]);
                    *(u32x4*)(O + (size_t)r * ldc + col0 + bj * HALF) = w;
                }
                asm volatile("" ::: "memory");
            }
    }
};

struct EpiSwiglu {
    bf16_t* O; int ldc; const float* ss;
    DI void operator()(const f32x4 (&acc)[2][2][4][2], const Unit& u, int wr, int wc, int fr, int fq) const {
        const int row0 = u.pm * BM + wr * 64 + fr, col0 = u.pn * 128 + wc * 32 + 8 * fq;
        float ssv[2][4];
#pragma unroll
        for (int ai = 0; ai < 2; ++ai)
#pragma unroll
            for (int m = 0; m < 4; ++m) ssv[ai][m] = ss[row0 + ai * HALF + m * 16];
#pragma unroll
        for (int ai = 0; ai < 2; ++ai)
#pragma unroll
            for (int m = 0; m < 4; ++m) {
                const int r = row0 + ai * HALF + m * 16;
                const float rs = __builtin_amdgcn_rsqf(ssv[ai][m] * (1.0f / 1024.0f) + EPS);
                float o[8];
#pragma unroll
                for (int n = 0; n < 2; ++n)
#pragma unroll
                    for (int e = 0; e < 4; ++e) { const float gg = acc[ai][0][m][n][e] * rs, uu = acc[ai][1][m][n][e] * rs; o[4 * n + e] = gg * sigmoidf_(gg) * uu; }
                u32x4 w; w.x = pk2(o[0], o[1]); w.y = pk2(o[2], o[3]); w.z = pk2(o[4], o[5]); w.w = pk2(o[6], o[7]);
                *(u32x4*)(O + (size_t)r * ldc + col0) = w;
                asm volatile("" ::: "memory");
            }
    }
};

struct EpiResid {
    const float* hin; float* hout; bf16_t* hb; float* ss_out; float scale;
    DI void operator()(const f32x4 (&acc)[2][2][4][2], const Unit& u, int wr, int wc, int fr, int fq) const {
        const int row0 = u.pm * BM + wr * 64 + fr, col0 = u.pn * BM + wc * 32 + 8 * fq;
        f32x4 hn[4][2][2];
#pragma unroll
        for (int g = 0; g < 4; ++g)
#pragma unroll
            for (int bj = 0; bj < 2; ++bj) { const size_t off = (size_t)(row0 + g * 16) * DM + col0 + bj * HALF; hn[g][bj][0] = *(const f32x4*)(hin + off); hn[g][bj][1] = *(const f32x4*)(hin + off + 4); }
#pragma unroll
        for (int ai = 0; ai < 2; ++ai)
#pragma unroll
            for (int m = 0; m < 4; ++m) {
                const int r = row0 + ai * HALF + m * 16;
                f32x4 hc[2][2];
#pragma unroll
                for (int bj = 0; bj < 2; ++bj) { hc[bj][0] = hn[m][bj][0]; hc[bj][1] = hn[m][bj][1]; }
                if (ai == 0) {
                    const int rn = row0 + HALF + m * 16;
#pragma unroll
                    for (int bj = 0; bj < 2; ++bj) { const size_t off = (size_t)rn * DM + col0 + bj * HALF; hn[m][bj][0] = *(const f32x4*)(hin + off); hn[m][bj][1] = *(const f32x4*)(hin + off + 4); }
                }
                float q = 0.f;
#pragma unroll
                for (int bj = 0; bj < 2; ++bj) {
                    const size_t off = (size_t)r * DM + col0 + bj * HALF;
                    f32x4 h0 = hc[bj][0], h1 = hc[bj][1];
                    h0 += acc[ai][bj][m][0] * scale; h1 += acc[ai][bj][m][1] * scale;
                    *(f32x4*)(hout + off) = h0; *(f32x4*)(hout + off + 4) = h1;
                    u32x4 w; w.x = pk2(h0[0], h0[1]); w.y = pk2(h0[2], h0[3]); w.z = pk2(h1[0], h1[1]); w.w = pk2(h1[2], h1[3]);
                    if (hb) *(u32x4*)(hb + off) = w;
                    q += h0[0] * h0[0] + h0[1] * h0[1] + h0[2] * h0[2] + h0[3] * h0[3] + h1[0] * h1[0] + h1[1] * h1[1] + h1[2] * h1[2] + h1[3] * h1[3];
                }
                q += __shfl_xor(q, 16); q += __shfl_xor(q, 32);
                if (fq == 0) unsafeAtomicAdd(ss_out + r, q);
                asm volatile("" ::: "memory");
            }
    }
};

struct EpiGate {
    const bf16_t* gate0; int ldg; const float* bias0; float* m32; bf16_t* mb;
    DI void operator()(f32x4 (&acc)[2][2][4][2], const Unit& u, int wr, int wc, int fr, int fq) const {
        const int b = u.pm / (TC / HALF), pm = u.pm - b * (TC / HALF), pn = u.pn - b * 4;
        const bool first = (b == 0), last = (b == 2);
        const bf16_t* gate = gate0 + b * 1024; const float* bias = bias0 + b * 1024;
        const int row0 = pm * HALF + wr * 64 + fr, col0 = pn * BM + wc * 32 + 8 * fq;
        f32x4 bz[2][2]; u32x4 gall[4][2];
#pragma unroll
        for (int bj = 0; bj < 2; ++bj) { bz[bj][0] = *(const f32x4*)(bias + col0 + bj * HALF); bz[bj][1] = *(const f32x4*)(bias + col0 + bj * HALF + 4); }
#pragma unroll
        for (int m = 0; m < 4; ++m)
#pragma unroll
            for (int bj = 0; bj < 2; ++bj) gall[m][bj] = *(const u32x4*)(gate + (size_t)(row0 + m * 16) * ldg + col0 + bj * HALF);
#pragma unroll
        for (int ai = 0; ai < 1; ++ai)
#pragma unroll
            for (int m = 0; m < 4; ++m) {
                const int r = row0 + ai * HALF + m * 16;
#pragma unroll
                for (int bj = 0; bj < 2; ++bj) {
                    const int c = col0 + bj * HALF;
                    const u32x4 gw = gall[m][bj];
                    const f32x4 b0 = bz[bj][0], b1 = bz[bj][1];
                    f32x4 v0, v1;
                    v0[0] = acc[ai][bj][m][0][0] * sigmoidf_(bflo(gw.x) + b0[0]); v0[1] = acc[ai][bj][m][0][1] * sigmoidf_(bfhi(gw.x) + b0[1]);
                    v0[2] = acc[ai][bj][m][0][2] * sigmoidf_(bflo(gw.y) + b0[2]); v0[3] = acc[ai][bj][m][0][3] * sigmoidf_(bfhi(gw.y) + b0[3]);
                    v1[0] = acc[ai][bj][m][1][0] * sigmoidf_(bflo(gw.z) + b1[0]); v1[1] = acc[ai][bj][m][1][1] * sigmoidf_(bfhi(gw.z) + b1[1]);
                    v1[2] = acc[ai][bj][m][1][2] * sigmoidf_(bflo(gw.w) + b1[2]); v1[3] = acc[ai][bj][m][1][3] * sigmoidf_(bfhi(gw.w) + b1[3]);
                    const size_t off = (size_t)r * DM + c;
                    if (!first) { v0 += acc[1][bj][m][0]; v1 += acc[1][bj][m][1]; }
                    if (!last) { acc[1][bj][m][0] = v0; acc[1][bj][m][1] = v1; }
                    else { u32x4 w; w.x = pk2(v0[0], v0[1]); w.y = pk2(v0[2], v0[3]); w.z = pk2(v1[0], v1[1]); w.w = pk2(v1[2], v1[3]); *(u32x4*)(mb + off) = w; }
                    asm volatile("" ::: "memory");
                }
            }
    }
};
}

struct AttnArgs {
    const bf16_t* Q; int ldq;
    const bf16_t* K; int ldk;
    const bf16_t* K2; int ldk2;
    const bf16_t* V; int ldv;
    bf16_t* O; int ldo;
    float* lse; int ldl;
    int q0, tstride, toff, nk;
    float c2;
    const float* biasg;
};
DI int crow(int i, int hh) { return (i & 3) + 8 * (i >> 2) + 4 * hh; }
#define MFMA32(a, b, c) __builtin_amdgcn_mfma_f32_32x32x16_bf16((a), (b), (c), 0, 0, 0)

template <int MODE> struct ACfg;
template <> struct ACfg<0> { static constexpr int DK = 128, DV = 128; };
template <> struct ACfg<1> { static constexpr int DK = 96, DV = 64; };
template <> struct ACfg<2> { static constexpr int DK = 64, DV = 64; };
template <> struct ACfg<3> { static constexpr int DK = 64, DV = 64; };

DI bf16x8 pack8(const f32x16& x, int s) {
    u32x4 p;
    p.x = pk2(x[8 * s + 0], x[8 * s + 1]); p.y = pk2(x[8 * s + 2], x[8 * s + 3]); p.z = pk2(x[8 * s + 4], x[8 * s + 5]); p.w = pk2(x[8 * s + 6], x[8 * s + 7]);
    return __builtin_bit_cast(bf16x8, p);
}

template <bool MASKED>
DI void sb_block(f32x16& s, int kb0, int qi, int hh, float c2, float& carry) {
    float kp[16], bt[16];
#pragma unroll
    for (int i = 0; i < 16; ++i) {
        const float t = ex2(-fabsf(s[i]) * c2);
        const float r = __builtin_amdgcn_rcpf(1.0f + t), tr = t * r;
        const bool pos = s[i] >= 0.f;
        float b = pos ? r : tr, k = pos ? tr : r;
        if (MASKED) { const bool valid = (kb0 + crow(i, hh)) < qi; b = valid ? b : 0.f; k = valid ? k : 1.f; }
        bt[i] = b; kp[i] = k;
    }
    float gs[4], pg[4];
#pragma unroll
    for (int q = 0; q < 4; ++q) gs[q] = (kp[4 * q] * kp[4 * q + 1]) * (kp[4 * q + 2] * kp[4 * q + 3]);
#pragma unroll
    for (int q = 0; q < 4; ++q) pg[q] = __shfl_xor(gs[q], 32);
    float run = carry;
#pragma unroll
    for (int q = 3; q >= 0; --q) {
        const float a3 = (hh == 0) ? run * pg[q] : run;
        const float a2 = a3 * kp[4 * q + 3], a1 = a2 * kp[4 * q + 2], a0 = a1 * kp[4 * q + 1];
        s[4 * q + 0] = bt[4 * q + 0] * a0; s[4 * q + 1] = bt[4 * q + 1] * a1; s[4 * q + 2] = bt[4 * q + 2] * a2; s[4 * q + 3] = bt[4 * q + 3] * a3;
        run *= gs[q] * pg[q];
    }
    carry = run;
}

template <int MODE>
DI void attn_unit(LAS unsigned char* lds, const AttnArgs a) {
    constexpr int DK = ACfg<MODE>::DK, DV = ACfg<MODE>::DV, KLD = DK + 8, VLD = 72, NKS = DK / 16, NDB = DV / 32;
    const int tid = ltid(), wid = __builtin_amdgcn_readfirstlane(tid >> 6), lane = tid & 63, r32 = lane & 31, hh = lane >> 5;
    constexpr bool SWZ = (DV == 64);
    constexpr int BUFE = 64 * KLD + DV * VLD;
    LAS bf16_t* Ks = (LAS bf16_t*)lds;
    LAS bf16_t* Vt = Ks + 64 * KLD;
    LAS float* biasL = (LAS float*)(Ks + 2 * BUFE);
    const int q0w = a.q0 + wid * 32, qi = q0w + r32;
    const size_t qtok = (size_t)a.toff + (size_t)qi * a.tstride;
    bf16x8 qf[NKS];
#pragma unroll
    for (int ks = 0; ks < NKS; ++ks) qf[ks] = *(const bf16x8*)(a.Q + qtok * a.ldq + ks * 16 + 8 * hh);
    if (MODE == 3) { __syncthreads(); if (tid < 129) biasL[tid] = a.biasg[tid]; }
    f32x16 o[NDB];
#pragma unroll
    for (int d = 0; d < NDB; ++d)
#pragma unroll
        for (int i = 0; i < 16; ++i) o[d][i] = 0.f;
    float mrow = -1e30f, lrow = 0.f, carry = 1.f;
    int ntile;
    if (MODE == 0) ntile = a.nk / 64; else if (MODE == 1) ntile = (a.q0 + 255) / 64 + 1; else if (MODE == 2) ntile = (a.q0 + 254) / 64 + 1; else ntile = 6;
    const int it0 = (MODE == 3 && a.q0 == 0) ? 2 : 0;
    constexpr int NKC = (64 * (DK / 8) + 511) / 512, NVC = (64 * (DV / 8) + 511) / 512;
    u32x4 kreg[NKC], vreg[NVC];
#define ATT_KBASE(it_) ((MODE == 2) ? (ntile - 1 - (it_)) * 64 : ((MODE == 3) ? a.q0 - 128 + (it_) * 64 : (it_) * 64))
#define ATT_LOAD(it_) do { const int kb_ = ATT_KBASE(it_); \
        _Pragma("unroll") for (int i_ = 0; i_ < NKC; ++i_) { const int c = tid + i_ * 512; if (c < 64 * (DK / 8)) { \
            const int row = c / (DK / 8), ch = c % (DK / 8); int kj = kb_ + row; if (MODE == 3) kj = kj < 0 ? 0 : kj; \
            const size_t tok = (size_t)a.toff + (size_t)kj * a.tstride; \
            const bf16_t* src = (MODE == 1 && ch >= 8) ? (a.K2 + tok * a.ldk2 + (ch - 8) * 8) : (a.K + tok * a.ldk + ch * 8); \
            kreg[i_] = *(const u32x4*)src; } } \
        _Pragma("unroll") for (int i_ = 0; i_ < NVC; ++i_) { const int c = tid + i_ * 512; \
            const int row = c / (DV / 8), ch = c % (DV / 8); int kj = kb_ + row; if (MODE == 3) kj = kj < 0 ? 0 : kj; \
            const size_t tok = (size_t)a.toff + (size_t)kj * a.tstride; \
            vreg[i_] = *(const u32x4*)(a.V + tok * a.ldv + ch * 8); } } while (0)
#define ATT_STORE(b_) do { LAS bf16_t* Kd = Ks + (b_) * BUFE; LAS bf16_t* Vd = Vt + (b_) * BUFE; \
        _Pragma("unroll") for (int i_ = 0; i_ < NKC; ++i_) { const int c = tid + i_ * 512; if (c < 64 * (DK / 8)) { const int row = c / (DK / 8), ch = c % (DK / 8); *(LAS u32x4*)(Kd + row * KLD + ch * 8) = kreg[i_]; } } \
        _Pragma("unroll") for (int i_ = 0; i_ < NVC; ++i_) { \
            const int c = tid + i_ * 512, row = c / (DV / 8), ch = c % (DV / 8); \
            const u32x4 v = vreg[i_]; \
            LAS bf16_t* dst = Vd + (ch * 8) * VLD + (row ^ (SWZ ? ((ch & 7) << 2) : 0));   \
            dst[0 * VLD] = (bf16_t)(v.x & 0xffff); dst[1 * VLD] = (bf16_t)(v.x >> 16); \
            dst[2 * VLD] = (bf16_t)(v.y & 0xffff); dst[3 * VLD] = (bf16_t)(v.y >> 16); \
            dst[4 * VLD] = (bf16_t)(v.z & 0xffff); dst[5 * VLD] = (bf16_t)(v.z >> 16); \
            dst[6 * VLD] = (bf16_t)(v.w & 0xffff); dst[7 * VLD] = (bf16_t)(v.w >> 16); } } while (0)
    ATT_LOAD(it0);
    ATT_STORE(0);
    __syncthreads();
    if (it0 + 1 < ntile) ATT_LOAD(it0 + 1);
    bool sb_dead = false;
    for (int it = it0; it < ntile; ++it) {
        const int kbase = ATT_KBASE(it), cur = (it - it0) & 1;
        const LAS bf16_t* Kc = Ks + cur * BUFE; const LAS bf16_t* Vc = Vt + cur * BUFE;
        bool active = true;
        if (MODE == 1) active = kbase <= q0w + 31;
        if (MODE == 2) active = (kbase <= q0w + 30) && !sb_dead;
        if (MODE == 3) active = (kbase + 63 >= q0w - 128) && (kbase <= q0w + 31);
        if (active) {
        f32x16 s0, s1;
#pragma unroll
        for (int i = 0; i < 16; ++i) { s0[i] = 0.f; s1[i] = 0.f; }
#pragma unroll
        for (int ks = 0; ks < NKS; ++ks) {
            const bf16x8 a0 = *(const LAS bf16x8*)(Kc + r32 * KLD + ks * 16 + 8 * hh);
            const bf16x8 a1 = *(const LAS bf16x8*)(Kc + (32 + r32) * KLD + ks * 16 + 8 * hh);
            s0 = MFMA32(a0, qf[ks], s0); s1 = MFMA32(a1, qf[ks], s1);
        }
        if (MODE == 2) {
            if (kbase + 63 < q0w) { sb_block<false>(s1, kbase + 32, qi, hh, a.c2, carry); sb_block<false>(s0, kbase, qi, hh, a.c2, carry); }
            else                  { sb_block<true>(s1, kbase + 32, qi, hh, a.c2, carry);  sb_block<true>(s0, kbase, qi, hh, a.c2, carry); }
        } else {
            const bool interior = (MODE == 0) || (MODE == 1 && kbase + 63 <= q0w);
            float mnew, alpha, ls = 0.f;
            if (interior) {
#pragma unroll
                for (int i = 0; i < 16; ++i) { s0[i] *= a.c2; s1[i] *= a.c2; }
                float mx = max3f(s0[0], s1[0], s0[1]);
                mx = max3f(mx, s1[1], s0[2]); mx = max3f(mx, s1[2], s0[3]); mx = max3f(mx, s1[3], s0[4]); mx = max3f(mx, s1[4], s0[5]);
                mx = max3f(mx, s1[5], s0[6]); mx = max3f(mx, s1[6], s0[7]); mx = max3f(mx, s1[7], s0[8]); mx = max3f(mx, s1[8], s0[9]);
                mx = max3f(mx, s1[9], s0[10]); mx = max3f(mx, s1[10], s0[11]); mx = max3f(mx, s1[11], s0[12]); mx = max3f(mx, s1[12], s0[13]);
                mx = max3f(mx, s1[13], s0[14]); mx = max3f(mx, s1[14], s0[15]); mx = fmaxf(mx, s1[15]);
                mx = fmaxf(mx, __shfl_xor(mx, 32));
                mnew = fmaxf(mrow, mx); alpha = ex2(mrow - mnew);
#pragma unroll
                for (int i = 0; i < 16; ++i) {
                    const float p0 = ex2(s0[i] - mnew), p1 = ex2(s1[i] - mnew);
                    s0[i] = p0; s1[i] = p1; ls += p0 + p1;
                }
            } else {
                float mx = -1e30f;
#pragma unroll
                for (int i = 0; i < 16; ++i) {
                    const int k0 = kbase + crow(i, hh), k1 = k0 + 32;
                    float x0 = s0[i] * a.c2, x1 = s1[i] * a.c2;
                    bool v0 = true, v1 = true;
                    if (MODE == 1) { v0 = k0 <= qi; v1 = k1 <= qi; }
                    if (MODE == 3) {
                        const int st0 = qi - k0, st1 = qi - k1;
                        v0 = (st0 >= 0) && (st0 <= 128) && (k0 >= 0); v1 = (st1 >= 0) && (st1 <= 128) && (k1 >= 0);
                        x0 += biasL[min(max(st0, 0), 128)]; x1 += biasL[min(max(st1, 0), 128)];
                    }
                    x0 = v0 ? x0 : -1e30f; x1 = v1 ? x1 : -1e30f;
                    s0[i] = x0; s1[i] = x1; mx = fmaxf(mx, fmaxf(x0, x1));
                }
                mx = fmaxf(mx, __shfl_xor(mx, 32));
                mnew = fmaxf(mrow, mx); alpha = ex2(mrow - mnew);
#pragma unroll
                for (int i = 0; i < 16; ++i) {
                    const float p0 = (s0[i] > -1e29f) ? ex2(s0[i] - mnew) : 0.f, p1 = (s1[i] > -1e29f) ? ex2(s1[i] - mnew) : 0.f;
                    s0[i] = p0; s1[i] = p1; ls += p0 + p1;
                }
            }
            mrow = mnew;
            lrow = lrow * alpha + ls;
            if (__ballot(alpha < 1.0f) != 0ull) {
#pragma unroll
                for (int d = 0; d < NDB; ++d)
#pragma unroll
                    for (int i = 0; i < 16; ++i) o[d][i] *= alpha;
            }
        }
        const bf16x8 pb00 = pack8(s0, 0), pb01 = pack8(s0, 1), pb10 = pack8(s1, 0), pb11 = pack8(s1, 1);
#pragma unroll
        for (int d = 0; d < NDB; ++d) {
            const LAS bf16_t* vp = Vc + (d * 32 + r32) * VLD;
            const int sw = SWZ ? ((((d * 32 + r32) >> 3) & 7) << 2) : 0;
#define VFRAG(off) __builtin_shufflevector(*(const LAS s16x4*)(vp + (((off) + 4 * hh) ^ sw)), *(const LAS s16x4*)(vp + (((off) + 8 + 4 * hh) ^ sw)), 0, 1, 2, 3, 4, 5, 6, 7)
            o[d] = MFMA32(VFRAG(0), pb00, o[d]);
            o[d] = MFMA32(VFRAG(16), pb01, o[d]);
            o[d] = MFMA32(VFRAG(32), pb10, o[d]);
            o[d] = MFMA32(VFRAG(48), pb11, o[d]);
#undef VFRAG
        }
        }
        if (it + 1 < ntile) ATT_STORE(cur ^ 1);
        if (MODE == 2) {
            sb_dead = (__ballot(carry != 0.f) == 0ull);
            if (!__syncthreads_or(sb_dead ? 0 : 1)) break;
        } else __syncthreads();
        if (it + 2 < ntile) ATT_LOAD(it + 2);
    }
    float inv = 1.f;
    if (MODE != 2) {
        const float lt = lrow + __shfl_xor(lrow, 32);
        inv = 1.0f / lt;
        if (MODE == 3 && hh == 0) a.lse[qtok * a.ldl] = mrow + lg2(lt);
    }
#pragma unroll
    for (int d = 0; d < NDB; ++d)
#pragma unroll
        for (int g4 = 0; g4 < 4; ++g4) {
            u32x2 w; w.x = pk2(o[d][4 * g4] * inv, o[d][4 * g4 + 1] * inv); w.y = pk2(o[d][4 * g4 + 2] * inv, o[d][4 * g4 + 3] * inv);
            *(u32x2*)(a.O + qtok * a.ldo + d * 32 + 8 * g4 + 4 * hh) = w;
        }
}

DI void attn_dil_unit(LAS unsigned char* lds, const AttnArgs a) {
    constexpr int KLD = 72, VLD = 392, NK = 384;
    const int tid = ltid(), wid = __builtin_amdgcn_readfirstlane(tid >> 6), lane = tid & 63, r32 = lane & 31, hh = lane >> 5;
    LAS bf16_t* Kl = (LAS bf16_t*)lds;
    LAS bf16_t* Vl = Kl + NK * KLD;
    LAS float* biasL = (LAS float*)(Vl + 64 * VLD);
    const int q0w = a.q0 + wid * 32, qi = q0w + r32;
    const size_t qtok = (size_t)a.toff + (size_t)qi * a.tstride;
    bf16x8 qf[4];
#pragma unroll
    for (int ks = 0; ks < 4; ++ks) qf[ks] = *(const bf16x8*)(a.Q + qtok * a.ldq + ks * 16 + 8 * hh);
    {
        u32x4 kr[6], vr[6];
#pragma unroll
        for (int i = 0; i < 6; ++i) {
            const int c = tid + 512 * i, row = c >> 3, ch = c & 7;
            int kj = a.q0 - 128 + row; kj = kj < 0 ? 0 : kj;
            const size_t tok = (size_t)a.toff + (size_t)kj * a.tstride;
            kr[i] = *(const u32x4*)(a.K + tok * a.ldk + ch * 8);
            vr[i] = *(const u32x4*)(a.V + tok * a.ldv + ch * 8);
        }
        const float bv = (tid < 129) ? a.biasg[tid] : 0.f;
        __syncthreads();
        if (tid < 129) biasL[tid] = bv;
#pragma unroll
        for (int i = 0; i < 6; ++i) {
            const int c = tid + 512 * i, row = c >> 3, ch = c & 7;
            *(LAS u32x4*)(Kl + row * KLD + ch * 8) = kr[i];
            const u32x4 v = vr[i];
            LAS bf16_t* dst = Vl + (ch * 8) * VLD + (row ^ (ch << 2));
            dst[0 * VLD] = (bf16_t)(v.x & 0xffff); dst[1 * VLD] = (bf16_t)(v.x >> 16);
            dst[2 * VLD] = (bf16_t)(v.y & 0xffff); dst[3 * VLD] = (bf16_t)(v.y >> 16);
            dst[4 * VLD] = (bf16_t)(v.z & 0xffff); dst[5 * VLD] = (bf16_t)(v.z >> 16);
            dst[6 * VLD] = (bf16_t)(v.w & 0xffff); dst[7 * VLD] = (bf16_t)(v.w >> 16);
        }
    }
    __syncthreads();
    f32x16 sc[5];
#pragma unroll
    for (int j = 0; j < 5; ++j) {
#pragma unroll
        for (int i = 0; i < 16; ++i) sc[j][i] = 0.f;
#pragma unroll
        for (int ks = 0; ks < 4; ++ks) {
            const bf16x8 kf = *(const LAS bf16x8*)(Kl + (32 * wid + 32 * j + r32) * KLD + ks * 16 + 8 * hh);
            sc[j] = MFMA32(kf, qf[ks], sc[j]);
        }
    }
    float mx = -1e30f;
#pragma unroll
    for (int j = 0; j < 5; ++j)
#pragma unroll
        for (int i = 0; i < 16; ++i) {
            const int st = r32 + 128 - 32 * j - crow(i, hh);
            const int kj = qi - st;
            const bool valid = (st >= 0) && (st <= 128) && (kj >= 0);
            float x = sc[j][i] * a.c2 + biasL[min(max(st, 0), 128)];
            x = valid ? x : -1e30f;
            sc[j][i] = x; mx = fmaxf(mx, x);
        }
    mx = fmaxf(mx, __shfl_xor(mx, 32));
    float ls = 0.f;
#pragma unroll
    for (int j = 0; j < 5; ++j)
#pragma unroll
        for (int i = 0; i < 16; ++i) { const float p = (sc[j][i] > -1e29f) ? ex2(sc[j][i] - mx) : 0.f; sc[j][i] = p; ls += p; }
    const float lt = ls + __shfl_xor(ls, 32);
    f32x16 o[2];
#pragma unroll
    for (int d = 0; d < 2; ++d)
#pragma unroll
        for (int i = 0; i < 16; ++i) o[d][i] = 0.f;
#pragma unroll
    for (int j = 0; j < 5; ++j) {
        const bf16x8 pb0 = pack8(sc[j], 0), pb1 = pack8(sc[j], 1);
#pragma unroll
        for (int d = 0; d < 2; ++d) {
            const LAS bf16_t* vp = Vl + (d * 32 + r32) * VLD + 32 * wid + 32 * j;
            const int sw = (((d * 32 + r32) >> 3) & 7) << 2;
#define VFRAG2(off) __builtin_shufflevector(*(const LAS s16x4*)(vp + (((off) + 4 * hh) ^ sw)), *(const LAS s16x4*)(vp + (((off) + 8 + 4 * hh) ^ sw)), 0, 1, 2, 3, 4, 5, 6, 7)
            o[d] = MFMA32(VFRAG2(0), pb0, o[d]);
            o[d] = MFMA32(VFRAG2(16), pb1, o[d]);
#undef VFRAG2
        }
    }
    const float inv = 1.0f / lt;
    if (hh == 0) a.lse[qtok * a.ldl] = mx + lg2(lt);
#pragma unroll
    for (int d = 0; d < 2; ++d)
#pragma unroll
        for (int g4 = 0; g4 < 4; ++g4) {
            u32x2 w; w.x = pk2(o[d][4 * g4] * inv, o[d][4 * g4 + 1] * inv); w.y = pk2(o[d][4 * g4 + 2] * inv, o[d][4 * g4 + 3] * inv);
            *(u32x2*)(a.O + qtok * a.ldo + d * 32 + 8 * g4 + 4 * hh) = w;
        }
}

struct Params { const float* in[28]; float* out; unsigned char* ws; int ph_lo, ph_hi; };
typedef const __attribute__((address_space(4))) unsigned char* kptr_t;
#define KIN(i) (*(const float* const __attribute__((address_space(4)))*)(kb + 8 * (i)))
#define KOUT (*(float* const __attribute__((address_space(4)))*)(kb + 224))
#define KWS (*(unsigned char* const __attribute__((address_space(4)))*)(kb + 232))


DI float wave_sum(float v) {
#pragma unroll
    for (int o = 32; o >= 1; o >>= 1) v += __shfl_xor(v, o);
    return v;
}

struct WDesc { const float* s0; const float* s1; const float* gain; bf16_t* dst; int nrows, kdst, ksrc, ldsrc, map; };

DI int convert_weight(LAS unsigned char* lds, const WDesc d, int G, int bid, int goff) {
    LAS bf16_t* tl = (LAS bf16_t*)lds;
    const int tid = ltid();
    const int nkt = d.kdst / 64, ntile = (d.nrows / 64) * nkt;
    const int ngrp = (ntile + 3) >> 2;
    int g0 = (bid - goff) % G; if (g0 < 0) g0 += G;
    for (int t0 = g0 * 4; t0 < ntile; t0 += G * 4) {
        float v[4][8];
#pragma unroll
        for (int j = 0; j < 4; ++j) {
            const int t = t0 + j, tc = t / nkt, tk = t % nkt;
            const int cc = tid & 63, c = tc * 64 + cc;
            int col; const float* src = d.s0;
            if (d.map == 0) col = c;
            else if (d.map == 1) { col = (c >> 8) * 128 + (c & 127); if (c & 128) src = d.s1; }
            else { col = c < 2080 ? c : (c < 2304 ? -1 : c - 224); }
#pragma unroll
            for (int i = 0; i < 8; ++i) {
                const int kk = (tid >> 6) + 8 * i, k = tk * 64 + kk;
                float x = 0.f;
                if (t < ntile && col >= 0 && k < d.ksrc) { x = src[(size_t)k * d.ldsrc + col]; if (d.gain) x *= d.gain[k]; }
                v[j][i] = x;
            }
        }
        __syncthreads();
#pragma unroll
        for (int j = 0; j < 4; ++j)
#pragma unroll
            for (int i = 0; i < 8; ++i) tl[j * 64 * 66 + (tid & 63) * 66 + (tid >> 6) + 8 * i] = (bf16_t)(pk2(v[j][i], 0.f) & 0xffff);
        __syncthreads();
#pragma unroll
        for (int j = 0; j < 4; ++j) {
            const int t = t0 + j, tc = t / nkt, tk = t % nkt;
            const int rr = tid >> 3, kc = tid & 7;
            const LAS unsigned* sp = (const LAS unsigned*)(tl + j * 64 * 66 + rr * 66 + kc * 8);
            u32x4 w; w.x = sp[0]; w.y = sp[1]; w.z = sp[2]; w.w = sp[3];
            if (t < ntile) *(u32x4*)(d.dst + (size_t)(tc * 64 + rr) * d.kdst + tk * 64 + kc * 8) = w;
        }
    }
    return goff + ngrp;
}

DI WDesc wdesc(kptr_t kb, bf16_t* wl, int l, int id) {
    WDesc d; d.s1 = nullptr; d.gain = nullptr; d.map = 0;
    switch (id) {
    case 0: d.s0 = KIN(3) + (size_t)l * 1024 * 2816; d.s1 = KIN(4) + (size_t)l * 1024 * 2816; d.gain = KIN(2) + l * 1024; d.dst = wl + WO_GU1; d.nrows = 5632; d.kdst = 1024; d.ksrc = 1024; d.ldsrc = 2816; d.map = 1; break;
    case 1: d.s0 = KIN(5) + (size_t)l * 2816 * 1024; d.dst = wl + WO_D1; d.nrows = 1024; d.kdst = 2816; d.ksrc = 2816; d.ldsrc = 1024; break;
    case 2: d.s0 = KIN(7) + (size_t)l * 1024 * 9760; d.gain = KIN(6) + l * 1024; d.dst = wl + WO_IN; d.nrows = NINP; d.kdst = 1024; d.ksrc = 1024; d.ldsrc = 9760; d.map = 2; break;
    case 3: d.s0 = KIN(10) + (size_t)l * 384 * 768; d.gain = KIN(9) + l * 384; d.dst = wl + WO_UQ; d.nrows = 768; d.kdst = 384; d.ksrc = 384; d.ldsrc = 768; break;
    case 4: d.s0 = KIN(12) + (size_t)l * 128 * 1024; d.gain = KIN(11) + l * 128; d.dst = wl + WO_UKV; d.nrows = 1024; d.kdst = 256; d.ksrc = 128; d.ldsrc = 1024; break;
    case 5: d.s0 = KIN(13) + (size_t)l * 512 * 1024; d.dst = wl + WO_BA; d.nrows = 1024; d.kdst = 512; d.ksrc = 512; d.ldsrc = 1024; break;
    case 6: d.s0 = KIN(14) + (size_t)l * 512 * 1024; d.dst = wl + WO_BB; d.nrows = 1024; d.kdst = 512; d.ksrc = 512; d.ldsrc = 1024; break;
    case 7: d.s0 = KIN(15) + (size_t)l * 512 * 1024; d.dst = wl + WO_BC; d.nrows = 1024; d.kdst = 512; d.ksrc = 512; d.ldsrc = 1024; break;
    case 8: d.s0 = KIN(16) + (size_t)l * 1024 * 1024; d.dst = wl + WO_MO; d.nrows = 1024; d.kdst = 1024; d.ksrc = 1024; d.ldsrc = 1024; break;
    case 9: d.s0 = KIN(20) + (size_t)l * 1024 * 512; d.gain = KIN(18) + l * 1024; d.dst = wl + WO_XQ; d.nrows = 512; d.kdst = 1024; d.ksrc = 1024; d.ldsrc = 512; break;
    case 10: d.s0 = KIN(21) + (size_t)l * 1024 * 1024; d.gain = KIN(19) + l * 1024; d.dst = wl + WO_XKV; d.nrows = 1024; d.kdst = 1024; d.ksrc = 1024; d.ldsrc = 1024; break;
    case 11: d.s0 = KIN(22) + (size_t)l * 512 * 1024; d.dst = wl + WO_XO; d.nrows = 1024; d.kdst = 512; d.ksrc = 512; d.ldsrc = 1024; break;
    case 12: d.s0 = KIN(24) + (size_t)l * 1024 * 2816; d.s1 = KIN(25) + (size_t)l * 1024 * 2816; d.gain = KIN(23) + l * 1024; d.dst = wl + WO_GU2; d.nrows = 5632; d.kdst = 1024; d.ksrc = 1024; d.ldsrc = 2816; d.map = 1; break;
    default: d.s0 = KIN(26) + (size_t)l * 2816 * 1024; d.dst = wl + WO_D2; d.nrows = 1024; d.kdst = 2816; d.ksrc = 2816; d.ldsrc = 1024; break;
    }
    return d;
}

DI void rows_to_bf16(const float* src, bf16_t* dst, float* ss, int nrows, int gw, int nw) {
    const int lane = ltid() & 63;
    for (int r = gw; r < nrows; r += nw) {
        float q = 0.f;
#pragma unroll
        for (int i = 0; i < 4; ++i) {
            const f32x4 v = *(const f32x4*)(src + (size_t)r * 1024 + i * 256 + lane * 4);
            q += v[0] * v[0] + v[1] * v[1] + v[2] * v[2] + v[3] * v[3];
            u32x2 w; w.x = pk2(v[0], v[1]); w.y = pk2(v[2], v[3]);
            *(u32x2*)(dst + (size_t)r * 1024 + i * 256 + lane * 4) = w;
        }
        q = wave_sum(q);
        if (lane == 0) ss[r] = q;
    }
}


#define XB_TMO      128
#define XB_XCNT(j)  (256  + 64 * (j))
#define XB_XSUB(j)  (1280 + 64 * (j))
#define XB_XGEN(j)  (2304 + 64 * (j))
#define XB_TOP      3328
#define XB_TOPGEN   3392
#define XCD_BAR_WORDS 3456
#define XB_SPIN_CAP (1u << 20)
DI unsigned xb_ld(unsigned* p)              { return __hip_atomic_load(p, __ATOMIC_RELAXED, __HIP_MEMORY_SCOPE_AGENT); }
DI unsigned xb_add(unsigned* p, unsigned v) { return __hip_atomic_fetch_add(p, v, __ATOMIC_RELAXED, __HIP_MEMORY_SCOPE_AGENT); }
DI unsigned xb_xcc_id() { return (unsigned)__builtin_amdgcn_s_getreg((3 << 11) | 20) & 0xFu; }
#define XB_SPIN(cond, bar) do { unsigned _sp = 0; while (cond) { __builtin_amdgcn_s_sleep(1); \
    if ((++_sp & 255u) == 0u) { if (xb_ld(&(bar)[XB_TMO])) break; if (_sp > XB_SPIN_CAP) { atomicAdd(&(bar)[XB_TMO], 1u); break; } } } } while (0)
DI void xcd_barrier_complete(unsigned* bar, unsigned x, unsigned& nloc, unsigned& nx) {
    const unsigned G = gridDim.x * gridDim.y * gridDim.z;
    unsigned sum, cnt, mine, sp = 0u;
    for (;;) {
        sum = 0u; cnt = 0u; mine = 0u;
#pragma unroll
        for (unsigned j = 0; j < 16; ++j) { const unsigned c = xb_ld(&bar[XB_XCNT(j)]); sum += c; cnt += (c > 0u) ? 1u : 0u; mine = (j == x) ? c : mine; }
        if (sum == G) break;
        __builtin_amdgcn_s_sleep(1);
        if ((++sp & 255u) == 0u) { if (xb_ld(&bar[XB_TMO])) break; if (sp > XB_SPIN_CAP) { atomicAdd(&bar[XB_TMO], 1u); break; } }
    }
    nloc = mine > 0u ? mine : 1u; nx = cnt > 0u ? cnt : 1u;
}
DI void xcd_barrier(unsigned* bar, volatile LAS unsigned* st) {
    asm volatile("s_waitcnt vmcnt(0)" ::: "memory");
    __syncthreads();
    if (threadIdx.x == 0) {
        const unsigned x = xb_xcc_id();
        __builtin_amdgcn_s_waitcnt(0);
        unsigned nloc = st[0], nx = st[1];
        if (nloc == 0u) { xcd_barrier_complete(bar, x, nloc, nx); st[0] = nloc; st[1] = nx; }
        const unsigned old = xb_add(&bar[XB_XSUB(x)], 1u);
        const unsigned gen = old / nloc;
        if (old + 1u == (gen + 1u) * nloc) {
            __builtin_amdgcn_fence(__ATOMIC_RELEASE, "agent");
            asm volatile("s_waitcnt vmcnt(0)" ::: "memory");
            const unsigned og = xb_add(&bar[XB_TOP], 1u);
            const unsigned tg = og / nx;
            if (og + 1u == (tg + 1u) * nx) xb_add(&bar[XB_TOPGEN], 1u);
            else XB_SPIN(xb_ld(&bar[XB_TOPGEN]) == tg, bar);
            __builtin_amdgcn_fence(__ATOMIC_ACQUIRE, "agent");
            xb_add(&bar[XB_XGEN(x)], 1u);
            asm volatile("s_waitcnt vmcnt(0)" ::: "memory");
        } else {
            XB_SPIN(xb_ld(&bar[XB_XGEN(x)]) == gen, bar);
            __builtin_amdgcn_fence(__ATOMIC_ACQUIRE, "agent");
            asm volatile("s_waitcnt vmcnt(0)" ::: "memory");
        }
    }
    __syncthreads();
}

enum { OP_NONE = 0, OP_PROLOGUE, OP_SWIGLU, OP_SCALED0, OP_SCALED1, OP_SCALED2, OP_RESID, OP_GATE, OP_ATT_SBDIL, OP_ATT_MLA, OP_ATT_CROSS, OP_FINAL };
DI int op_kind(int ph, int op) {
    if (ph == 0) return op == 0 ? OP_PROLOGUE : OP_NONE;
    if (ph == 49) return op == 0 ? OP_FINAL : OP_NONE;
    const int k = (ph - 1) % 24;
    if (k == 0) return op == 0 ? OP_SWIGLU : OP_NONE;
    if (k == 1 || k == 18 || k == 21 || k == 23) return op == 0 ? OP_RESID : OP_NONE;
    if (k == 19) return op == 0 ? OP_SCALED0 : OP_NONE;
    if (k == 20) return op == 0 ? OP_ATT_CROSS : OP_NONE;
    if (k == 22) return op == 0 ? OP_SWIGLU : OP_NONE;
    const int sub = (k - 2) & 3;
    if (sub == 0) return op == 0 ? OP_SCALED1 : OP_NONE;
    if (sub == 1) return op == 0 ? OP_SCALED2 : (op == 1 ? OP_SCALED0 : OP_ATT_SBDIL);
    if (sub == 2) return op == 0 ? OP_ATT_MLA : OP_NONE;
    return op == 0 ? OP_GATE : ((op == 1 && k == 5) ? OP_SCALED0 : OP_NONE);
}

__global__ void __launch_bounds__(512, 2) mega(Params p) {
    extern __shared__ __attribute__((aligned(16))) unsigned char lds_raw[];
    LAS unsigned char* lds = (LAS unsigned char*)lds_raw;
    LAS int* s_item = (LAS int*)(lds + LDS_CTL);
    const kptr_t ka = (kptr_t)__builtin_amdgcn_kernarg_segment_ptr();
    volatile LAS unsigned* xb_st = (volatile LAS unsigned*)(lds + LDS_CTL + 16);
    if (threadIdx.x < 2) xb_st[threadIdx.x] = 0u;
    __syncthreads();
    const int ph_lo = *(const __attribute__((address_space(4))) int*)(ka + 240), ph_hi = *(const __attribute__((address_space(4))) int*)(ka + 244);
#define WSP(T_, off) ((T_*)(wsb + (off)))
#define QUEUE_BEGIN(n) for (;;) { __syncthreads(); if (tid == 0) *s_item = atomicAdd(WSP(int, WS_CTR) + ph + 50 * rep_, 1); __syncthreads(); const int item = *s_item; if (item >= (n)) break;
#define QUEUE_END }

#pragma unroll 1
    for (int ph = ph_lo; ph < ph_hi; ++ph) {
#pragma unroll 1
        for (int op = 0; op < 3; ++op) {
            const int kind = op_kind(ph, op);
            if (kind == OP_NONE) break;
            kptr_t kb = ka; asm volatile("" : "+s"(kb));
            unsigned char* wsb = KWS;
            const int G = gridDim.x, bid = blockIdx.x;
            const int l = (ph - 1) / 24, k = (ph - 1) % 24, ch = (k - 2) >> 2;
            const size_t row0 = (size_t)ch * TC;
            bf16_t* wl = WSP(bf16_t, WS_W) + (size_t)l * W_LAYER;
            float* ssz = WSP(float, WS_SSZ);
            unsigned char* R1 = wsb + WS_R1;
#pragma unroll 1
            for (int rep_ = 0; rep_ < ((kind == OP_ATT_SBDIL || kind == OP_ATT_MLA || kind == OP_ATT_CROSS) ? MK_REP_ATT : ((kind == OP_SWIGLU) ? MK_REP_GEMM : 1)); ++rep_)
            switch (kind) {
            case OP_PROLOGUE: {
#ifndef SKIP_OP_PROLOGUE
                const int tid = ltid();
                const int gw = bid * 8 + (tid >> 6), nw = G * 8;
                for (size_t i = (size_t)bid * 512 + tid; i < (size_t)NSSZ * T; i += (size_t)G * 512) ssz[i] = 0.f;
                if (bid == 0) { if (tid < 256) WSP(int, WS_CTR)[tid] = 0; for (int i = tid; i < XCD_BAR_WORDS; i += 512) WSP(unsigned, WS_BAR)[i] = 0u; }
                rows_to_bf16(KIN(0), WSP(bf16_t, WS_HB), WSP(float, WS_SS0), T, gw, nw);
                rows_to_bf16(KIN(1), WSP(bf16_t, WS_MEMB), WSP(float, WS_SSM), NB * MEML, gw, nw);
                float* rope = WSP(float, WS_ROPE);
                for (int i = bid * 512 + tid; i < SEQ * 16; i += G * 512) {
                    const int pos = i >> 4, fi = i & 15;
                    const float freq = exp2f(-(float)fi * (13.287712379549449f / 16.0f));
                    const float ang = (float)pos * freq;
                    const double rev = (double)ang * 0.15915494309189535;
                    const float fr = (float)(rev - rint(rev));
                    rope[2 * i] = __builtin_amdgcn_cosf(fr); rope[2 * i + 1] = __builtin_amdgcn_sinf(fr);
                }
                float* biasT = WSP(float, WS_BIAS);
                for (int i = bid * 512 + tid; i < 3 * 8 * 132; i += G * 512) {
                    const int g = i / (8 * 132), h = (i / 132) % 8, s = i % 132;
                    float v = 0.f;
                    if (s <= 128) {
                        const int r = (g == 0) ? 1 : (g == 1 ? 4 : 16), dist = s * r;
                        int bucket;
                        if (dist < 16) bucket = dist;
                        else { const float dd = (float)dist; const int large = 16 + (int)(logf(dd / 16.0f) / logf(128.0f) * 16.0f); bucket = large < 31 ? large : 31; }
                        v = KIN(17)[bucket * 24 + g * 8 + h] * LOG2E;
                    }
                    biasT[i] = v;
                }
                int goff_ = 0;
#pragma unroll 1
                for (int wi = 0; wi < 28; ++wi) goff_ = convert_weight(lds, wdesc(kb, WSP(bf16_t, WS_W) + (size_t)(wi / 14) * W_LAYER, wi / 14, wi % 14), G, bid, goff_);
#endif
            } break;
            case OP_SWIGLU: {
#ifndef SKIP_OP_SWIGLU
                const bool second = (k == 22);
                const float* ss_in = second ? (ssz + (size_t)(l * 4 + 2) * T) : (l == 0 ? WSP(float, WS_SS0) : ssz + (size_t)3 * T);
                pg8::Gemm g{WSP(bf16_t, WS_HB), wl + (second ? WO_GU2 : WO_GU1), 1024, 1024, T, 5632, 1024}; pg8::StaticOrder S; S.init(T, 5632, G, bid);
                pg8::EpiSwiglu E{(bf16_t*)(R1 + R_ACT), FF, ss_in}; pg8::gemm_phase(lds, g, S, E);
#endif
            } break;
            case OP_SCALED0: {
#ifndef SKIP_OP_SCALED0
                pg8::Gemm g; pg8::StaticOrder S; pg8::EpiScaled<0> E; E.ss_cq = nullptr; E.ss_ckv = nullptr; E.rope = nullptr;
                if (k == 5) {
                    g = pg8::Gemm{WSP(bf16_t, WS_MEMB), wl + WO_XKV, 1024, 1024, 2048, 1024, 1024}; S.init(2048, 1024, G, (bid + G - 128) % G);
                    E.O = WSP(bf16_t, WS_KVX) + (size_t)l * 2048 * 1024; E.ldc = 1024; E.ss = WSP(float, WS_SSM); E.inv_dim = 1.0f / 1024.0f;
                } else if (k == 19) {
                    g = pg8::Gemm{WSP(bf16_t, WS_HB), wl + WO_XQ, 1024, 1024, T, 512, 1024}; S.init(T, 512, G, bid);
                    E.O = (bf16_t*)(R1 + R_QX); E.ldc = 512; E.ss = ssz + (size_t)(l * 4 + 1) * T; E.inv_dim = 1.0f / 1024.0f;
                } else {
                    g = pg8::Gemm{(bf16_t*)(R1 + R_P) + C_CKV, wl + WO_UKV, NINP, 256, TC, 1024, 256}; S.init(TC, 1024, G, (bid + G - 96) % G);
                    E.O = (bf16_t*)(R1 + R_KVM); E.ldc = 1024; E.ss = ssz + (size_t)(9 + l * 2) * T + row0; E.inv_dim = 1.0f / 128.0f;
                }
                pg8::gemm_phase(lds, g, S, E);
#endif
            } break;
            case OP_SCALED1: {
#ifndef SKIP_OP_SCALED1
                pg8::Gemm g{WSP(bf16_t, WS_HB) + row0 * 1024, wl + WO_IN, 1024, 1024, TC, NINP, 1024}; pg8::StaticOrder S; S.init(TC, NINP, G, bid);
                pg8::EpiScaled<1> E{(bf16_t*)(R1 + R_P), NINP, ssz + (size_t)(l * 4 + 0) * T + row0, 1.0f / 1024.0f, ssz + (size_t)(8 + l * 2) * T + row0, ssz + (size_t)(9 + l * 2) * T + row0, WSP(float, WS_ROPE)};
                pg8::gemm_phase(lds, g, S, E);
#endif
            } break;
            case OP_SCALED2: {
#ifndef SKIP_OP_SCALED2
                pg8::Gemm g{(bf16_t*)(R1 + R_P) + C_CQ, wl + WO_UQ, NINP, 384, TC, 768, 384}; pg8::StaticOrder S; S.init(TC, 768, G, bid);
                pg8::EpiScaled<2> E{(bf16_t*)(R1 + R_QM), 768, ssz + (size_t)(8 + l * 2) * T + row0, 1.0f / 384.0f, nullptr, nullptr, WSP(float, WS_ROPE)};
                pg8::gemm_phase(lds, g, S, E);
#endif
            } break;
            case OP_RESID: {
#ifndef SKIP_OP_RESID
                const bool f1 = (k == 1), mo = (k == 18), xo = (k == 21);
                const size_t aoffb = mo ? R_MB : (xo ? R_OX : R_ACT);
                const size_t woff = f1 ? WO_D1 : (mo ? WO_MO : (xo ? WO_XO : WO_D2));
                const int kk = mo ? 1024 : (xo ? 512 : FF);
                const int ssi = l * 4 + (f1 ? 0 : (mo ? 1 : (xo ? 2 : 3)));
                float* const hout_ = KOUT;
                const float* const x_ = KIN(0);
                const float* const hin_ = (f1 && l == 0) ? x_ : (const float*)hout_;
                pg8::Gemm g{(bf16_t*)(R1 + aoffb), wl + woff, kk, kk, T, 1024, kk}; pg8::StaticOrder S; S.init(T, 1024, G, bid);
                pg8::EpiResid E{hin_, hout_, (l == 1 && k == 23) ? (bf16_t*)nullptr : WSP(bf16_t, WS_HB), ssz + (size_t)ssi * T, (mo || xo) ? 1.0f : 0.5f};
                pg8::gemm_phase(lds, g, S, E);
#endif
            } break;
            case OP_GATE: {
#ifndef SKIP_OP_GATE
                pg8::Gemm g{(bf16_t*)(R1 + R_OA), wl + WO_BA, 512, 512, 3 * TC, 3072, 512}; pg8::StaticOrder S; S.init(2 * TC, 1024, G, bid); S.passes(3, TC / 128, 4);
                pg8::EpiGate E{(bf16_t*)(R1 + R_P) + C_GATE, NINP, KIN(8) + (size_t)(l * 3) * 1024, (float*)(R1 + R_M32), (bf16_t*)(R1 + R_MB) + row0 * 1024};
                pg8::gemm_phase<pg8::EpiGate, true>(lds, g, S, E);
#endif
            } break;
            case OP_ATT_SBDIL: {
#ifndef SKIP_OP_ATT_SBDIL
                const int tid = ltid();
                bf16_t* P = (bf16_t*)(R1 + R_P);
                QUEUE_BEGIN(768)
                    {
                        const int j = item, g = j >> 8, bl = (j >> 7) & 1, h = (j >> 4) & 7, sub = j & 15;
                        const int r = (g == 0) ? 1 : (g == 1 ? 4 : 16), cls = sub % r, qt = sub / r;
                        const bf16_t* base = P + C_DIL + g * 1536 + h * 64;
                        AttnArgs a; a.Q = base; a.ldq = NINP; a.K = base + 512; a.ldk = NINP; a.K2 = nullptr; a.ldk2 = 0;
                        a.V = base + 1024; a.ldv = NINP; a.O = (bf16_t*)(R1 + R_OG) + (size_t)g * TC * 512 + h * 64; a.ldo = 512;
                        a.lse = (float*)(R1 + R_LSE) + (size_t)g * TC * 8 + h; a.ldl = 8;
                        a.q0 = qt * 256; a.tstride = r; a.toff = bl * SEQ + cls; a.nk = 0; a.c2 = 0.125f * LOG2E; a.biasg = WSP(float, WS_BIAS) + (g * 8 + h) * 132;
                        attn_dil_unit(lds, a);
                    }
                QUEUE_END
#endif
            } break;
            case OP_ATT_MLA: {
#ifndef SKIP_OP_ATT_MLA
                const int tid = ltid();
                QUEUE_BEGIN(512 + 256)
                    if (item >= 256 && item < 512) {
                        bf16_t* P = (bf16_t*)(R1 + R_P);
                        const int qt = 15 - ((item - 256) >> 4), bl = (item >> 3) & 1, h = item & 7;
                        AttnArgs a; a.Q = P + C_SBQ + h * 64; a.ldq = NINP; a.K = P + C_SBK + h * 64; a.ldk = NINP; a.K2 = nullptr; a.ldk2 = 0;
                        a.V = P + C_SBV + h * 64; a.ldv = NINP; a.O = (bf16_t*)(R1 + R_OA) + h * 64; a.ldo = 512; a.lse = nullptr; a.ldl = 0;
                        a.q0 = qt * 256; a.tstride = 1; a.toff = bl * SEQ; a.nk = 0; a.c2 = 0.125f * LOG2E; a.biasg = nullptr;
                        attn_unit<2>(lds, a);
                    } else if (item < 256) {
                        const int qt = 15 - (item >> 4), bl = (item >> 3) & 1, h = item & 7;
                        bf16_t* kvm = (bf16_t*)(R1 + R_KVM);
                        AttnArgs a; a.Q = (bf16_t*)(R1 + R_QM) + h * 96; a.ldq = 768; a.K = kvm + h * 128; a.ldk = 1024; a.K2 = (bf16_t*)(R1 + R_P) + C_KR; a.ldk2 = NINP;
                        a.V = kvm + h * 128 + 64; a.ldv = 1024; a.O = (bf16_t*)(R1 + R_OA) + (size_t)TC * 512 + h * 64; a.ldo = 512; a.lse = nullptr; a.ldl = 0;
                        a.q0 = qt * 256; a.tstride = 1; a.toff = bl * SEQ; a.nk = 0; a.c2 = 0.10206207261596577f * LOG2E; a.biasg = nullptr;
                        attn_unit<1>(lds, a);
                    } else {
                        const int t0 = (item - 512) * 32;
                        bf16_t* oc = (bf16_t*)(R1 + R_OA) + (size_t)2 * TC * 512;
                        const bf16_t* og = (const bf16_t*)(R1 + R_OG);
                        const float* lse = (const float*)(R1 + R_LSE);
#pragma unroll
                        for (int ps = 0; ps < 4; ++ps) {
                            const int tok = t0 + ps * 8 + (tid >> 6), c8 = (tid & 63) * 8, h = c8 >> 6;
                            const float l0 = lse[(size_t)tok * 8 + h], l1 = lse[(size_t)(TC + tok) * 8 + h], l2 = lse[(size_t)(2 * TC + tok) * 8 + h];
                            const float mx = fmaxf(l0, fmaxf(l1, l2));
                            float w0 = ex2(l0 - mx), w1 = ex2(l1 - mx), w2 = ex2(l2 - mx);
                            const float is = 1.0f / (w0 + w1 + w2); w0 *= is; w1 *= is; w2 *= is;
                            const u32x4 a0 = *(const u32x4*)(og + (size_t)tok * 512 + c8), a1 = *(const u32x4*)(og + (size_t)(TC + tok) * 512 + c8), a2 = *(const u32x4*)(og + (size_t)(2 * TC + tok) * 512 + c8);
                            u32x4 w;
                            w.x = pk2(w0 * bflo(a0.x) + w1 * bflo(a1.x) + w2 * bflo(a2.x), w0 * bfhi(a0.x) + w1 * bfhi(a1.x) + w2 * bfhi(a2.x));
                            w.y = pk2(w0 * bflo(a0.y) + w1 * bflo(a1.y) + w2 * bflo(a2.y), w0 * bfhi(a0.y) + w1 * bfhi(a1.y) + w2 * bfhi(a2.y));
                            w.z = pk2(w0 * bflo(a0.z) + w1 * bflo(a1.z) + w2 * bflo(a2.z), w0 * bfhi(a0.z) + w1 * bfhi(a1.z) + w2 * bfhi(a2.z));
                            w.w = pk2(w0 * bflo(a0.w) + w1 * bflo(a1.w) + w2 * bflo(a2.w), w0 * bfhi(a0.w) + w1 * bfhi(a1.w) + w2 * bfhi(a2.w));
                            *(u32x4*)(oc + (size_t)tok * 512 + c8) = w;
                        }
                    }
                QUEUE_END
#endif
            } break;
            case OP_ATT_CROSS: {
#ifndef SKIP_OP_ATT_CROSS
                const int tid = ltid();
                const bf16_t* kvxl = WSP(bf16_t, WS_KVX) + (size_t)l * 2048 * 1024;
                for (int item = bid; item < 512; item += G) {
                    const int b = item >> 6, h = (item >> 4) & 3, qt = item & 15;
                    AttnArgs a; a.Q = (bf16_t*)(R1 + R_QX) + (size_t)b * SEQ * 512 + h * 128; a.ldq = 512;
                    a.K = kvxl + (size_t)b * MEML * 1024 + h * 128; a.ldk = 1024; a.K2 = nullptr; a.ldk2 = 0;
                    a.V = kvxl + (size_t)b * MEML * 1024 + 512 + h * 128; a.ldv = 1024;
                    a.O = (bf16_t*)(R1 + R_OX) + (size_t)b * SEQ * 512 + h * 128; a.ldo = 512; a.lse = nullptr; a.ldl = 0;
                    a.q0 = qt * 256; a.tstride = 1; a.toff = 0; a.nk = MEML; a.c2 = 0.08838834764831845f * LOG2E; a.biasg = nullptr;
                    attn_unit<0>(lds, a);
                }
#endif
            } break;
            default: {
                const int tid = ltid();
                const float* ssf = ssz + (size_t)7 * T;
                const float* gf = KIN(27);
                float* hres = KOUT;
                const int lane = tid & 63;
                for (int r = bid * 8 + (tid >> 6); r < T; r += G * 8) {
                    const float rs = __builtin_amdgcn_rsqf(ssf[r] * (1.0f / 1024.0f) + EPS);
#pragma unroll
                    for (int i = 0; i < 4; ++i) {
                        const size_t off = (size_t)r * 1024 + i * 256 + lane * 4;
                        f32x4 v = *(const f32x4*)(hres + off); const f32x4 gg = *(const f32x4*)(gf + i * 256 + lane * 4);
                        v = v * rs * gg;
                        *(f32x4*)(hres + off) = v;
                    }
                }
            } break;
            }
        }
        if (ph + 1 < ph_hi) {
            kptr_t kb = ka; asm volatile("" : "+s"(kb));
            unsigned* bar = (unsigned*)(KWS + WS_BAR);
            if (ph == 0) {
                cg::this_grid().sync();
                if (threadIdx.x == 0) (void)xb_add(&bar[XB_XCNT(xb_xcc_id())], 1u);
            } else {
                for (int rs_ = 0; rs_ < MK_REP_SYNC; ++rs_) xcd_barrier(bar, xb_st);
            }
        }
    }
}

constexpr int N_PHASES = 50;

extern "C" void kernel_launch(void* const* d_in, const int* in_sizes, int n_in, void* d_out, int out_size, void* d_ws, size_t ws_size, hipStream_t stream) {
    static int grid = 0;
    if (grid == 0) {
        if (n_in != 28 || out_size != T * DM || ws_size < WS_END) { fprintf(stderr, "kernel_launch: unexpected shapes (n_in %d out %d ws %zu need %zu)\n", n_in, out_size, ws_size, (size_t)WS_END); grid = -1; return; }
        int dev = 0, cus = 0, per_cu = 0;
        hipGetDevice(&dev);
        hipDeviceGetAttribute(&cus, hipDeviceAttributeMultiprocessorCount, dev);
        if (hipFuncSetAttribute((const void*)mega, hipFuncAttributeMaxDynamicSharedMemorySize, LDS_BYTES) != hipSuccess) { fprintf(stderr, "kernel_launch: hipFuncSetAttribute failed\n"); grid = -1; return; }
        if (hipOccupancyMaxActiveBlocksPerMultiprocessor(&per_cu, (const void*)mega, 512, LDS_BYTES) != hipSuccess || per_cu < 1) { fprintf(stderr, "kernel_launch: occupancy query says %d\n", per_cu); per_cu = 1; }
        (void)hipGetLastError();
        grid = cus * 1;
        fprintf(stderr, "kernel_launch: grid %d (cus %d, per_cu %d)\n", grid, cus, per_cu);
    }
    if (grid < 0) return;
    Params p{};
    for (int i = 0; i < 28; ++i) p.in[i] = (const float*)d_in[i];
    p.out = (float*)d_out; p.ws = (unsigned char*)d_ws;
#if MK_PER_PHASE
    for (int k = MK_MINPH; k < MK_MAXPH; ++k) { p.ph_lo = k; p.ph_hi = k + 1; hipLaunchKernelGGL(mega, dim3(grid), dim3(512), LDS_BYTES, stream, p); }
#else
    p.ph_lo = 0; p.ph_hi = MK_MAXPH;
    void* args[] = {&p};
    hipError_t e = hipLaunchCooperativeKernel((const void*)mega, dim3(grid), dim3(512), args, LDS_BYTES, stream);
    if (e != hipSuccess) fprintf(stderr, "kernel_launch: cooperative launch failed: %s (grid %d)\n", hipGetErrorString(e), grid);
#endif
}
```

```cpp
#include <hip/hip_runtime.h>
#include <hip/hip_cooperative_groups.h>
#include <cstdio>
#include <cstdint>
namespace cg = cooperative_groups;

#ifndef MK_REP_SYNC
#define MK_REP_SYNC 1
#endif
#ifndef MK_REP_ATT
#define MK_REP_ATT 1
#endif
#ifndef MK_REP_GEMM
#define MK_REP_GEMM 1
#endif
#ifndef MK_MINPH
#define MK_MINPH 0
#endif
#ifndef MK_MAXPH
#define MK_MAXPH 50
#endif
#ifndef MK_PER_PHASE
#define MK_PER_PHASE 0
#endif

#define LAS __attribute__((address_space(3)))
#define DI __device__ __forceinline__
typedef unsigned short bf16_t;
typedef short bf16x8 __attribute__((ext_vector_type(8)));
typedef short s16x4 __attribute__((ext_vector_type(4)));
typedef float f32x4 __attribute__((ext_vector_type(4)));
typedef float f32x16 __attribute__((ext_vector_type(16)));
typedef unsigned u32x4 __attribute__((ext_vector_type(4)));
typedef unsigned u32x2 __attribute__((ext_vector_type(2)));
typedef float f32x2_t __attribute__((ext_vector_type(2)));
typedef __bf16 bf16x2_t __attribute__((ext_vector_type(2)));

DI unsigned pk2(float lo, float hi) { f32x2_t v = {lo, hi}; bf16x2_t b = __builtin_convertvector(v, bf16x2_t); return __builtin_bit_cast(unsigned, b); }
DI float bflo(unsigned u) { return __uint_as_float(u << 16); }
DI float bfhi(unsigned u) { return __uint_as_float(u & 0xffff0000u); }
DI float ex2(float x) { return __builtin_amdgcn_exp2f(x); }
DI float lg2(float x) { return __builtin_amdgcn_logf(x); }
DI float sigmoidf_(float x) { return __builtin_amdgcn_rcpf(1.0f + __builtin_amdgcn_exp2f(x * -1.4426950408889634f)); }
DI float max3f(float a, float b, float c) { float r; asm("v_max3_f32 %0, %1, %2, %3" : "=v"(r) : "v"(a), "v"(b), "v"(c)); return r; }
DI int ltid() { int t = threadIdx.x; asm volatile("" : "+v"(t)); return t; }

constexpr int T = 32768, DM = 1024, SEQ = 4096, NB = 8, FF = 2816, MEML = 256;
constexpr int TC = 8192, NCH = 4, BPC = 2;
constexpr int NINP = 9984;
constexpr int C_SBQ = 0, C_SBK = 512, C_SBV = 1024, C_CQ = 1536, C_CKV = 1920, C_KR = 2048, C_DIL = 2304, C_GATE = 6912;
constexpr float EPS = 1e-6f, LOG2E = 1.4426950408889634f;

constexpr size_t al(size_t x) { return (x + 255) & ~(size_t)255; }
constexpr size_t WS_CTR = 0;
constexpr size_t WS_BAR = 1024;
constexpr size_t WS_SSZ = 16384;
constexpr int    NSSZ = 12;
constexpr size_t WS_SS0 = WS_SSZ + (size_t)NSSZ * T * 4;
constexpr size_t WS_SSM = WS_SS0 + (size_t)T * 4;
constexpr size_t WS_ROPE = WS_SSM + 2048 * 4;
constexpr size_t WS_BIAS = WS_ROPE + (size_t)4096 * 16 * 8;
constexpr size_t WS_MEMB = al(WS_BIAS + 3 * 8 * 132 * 4);
constexpr size_t WS_KVX = WS_MEMB + (size_t)2048 * 1024 * 2;
constexpr size_t WS_HB = WS_KVX + (size_t)2 * 2048 * 1024 * 2;
constexpr size_t WS_W = WS_HB + (size_t)T * 1024 * 2;
constexpr size_t WO_GU1 = 0;
constexpr size_t WO_D1 = WO_GU1 + (size_t)5632 * 1024;
constexpr size_t WO_IN = WO_D1 + (size_t)1024 * 2816;
constexpr size_t WO_UQ = WO_IN + (size_t)NINP * 1024;
constexpr size_t WO_UKV = WO_UQ + (size_t)768 * 384;
constexpr size_t WO_BA = WO_UKV + (size_t)1024 * 256;
constexpr size_t WO_BB = WO_BA + (size_t)1024 * 512;
constexpr size_t WO_BC = WO_BB + (size_t)1024 * 512;
constexpr size_t WO_MO = WO_BC + (size_t)1024 * 512;
constexpr size_t WO_XQ = WO_MO + (size_t)1024 * 1024;
constexpr size_t WO_XKV = WO_XQ + (size_t)512 * 1024;
constexpr size_t WO_XO = WO_XKV + (size_t)1024 * 1024;
constexpr size_t WO_GU2 = WO_XO + (size_t)1024 * 512;
constexpr size_t WO_D2 = WO_GU2 + (size_t)5632 * 1024;
constexpr size_t W_LAYER = WO_D2 + (size_t)1024 * 2816;
constexpr size_t WS_R1 = WS_W + 2 * W_LAYER * 2;
constexpr size_t R_P = 0;
constexpr size_t R_QM = R_P + (size_t)TC * NINP * 2;
constexpr size_t R_KVM = R_QM + (size_t)TC * 768 * 2;
constexpr size_t R_OG = R_KVM + (size_t)TC * 1024 * 2;
constexpr size_t R_M32 = R_QM;
constexpr size_t R_OA = R_OG + (size_t)3 * TC * 512 * 2;
constexpr size_t R_LSE = R_OA + (size_t)3 * TC * 512 * 2;
constexpr size_t R_MB = R_LSE + (size_t)3 * TC * 8 * 4;
constexpr size_t R_END = R_MB + (size_t)T * 1024 * 2;
constexpr size_t R_ACT = 0;
constexpr size_t R_QX = 0;
constexpr size_t R_OX = (size_t)T * 512 * 2;
static_assert((size_t)TC * 1024 * 4 <= R_OA - R_QM, "m32 alias");
static_assert((size_t)T * FF * 2 <= R_END, "act fits");
constexpr size_t WS_END = WS_R1 + R_END;
static_assert(WS_END <= (size_t)512 * 1024 * 1024, "workspace");

constexpr int LDS_BYTES = 147456;
constexpr int LDS_CTL = 131072;

namespace pg8 {
constexpr int BM = 256, BK = 64, HALF = 128, HTB = HALF * BK * 2, STAGE_BYTES = 8 * HTB, NXCD = 8, WGM = 8;
DI int lds_byte(int r, int c) { const int st = (r >> 4) * 2 + (c >> 5), rr = r & 15, cc = c & 31, ob = rr * 64 + cc * 2; return st * 1024 + (ob ^ (((ob >> 9) & 1) << 5)); }
DI void stage_rc(int b, int& R, int& C) { const int st = b / 1024, sb = b % 1024, swz = sb ^ (((sb >> 9) & 1) << 5); R = (st >> 1) * 16 + swz / 64; C = (st & 1) * 32 + (swz % 64) / 2; }
DI int perm32(int rho) { const int n = rho >> 4, i = rho & 15; return 8 * (i >> 2) + 4 * n + (i & 3); }
struct Unit { int pm, pn; };
struct Gemm { const bf16_t* A; const bf16_t* Bt; int lda, ldb, M, N, K; };
struct StaticOrder {
    int nM, nN, nwg, G, c, npass, pms, pns;
    DI void init(int M, int N, int G_, int c_) { nM = M / BM; nN = N / BM; nwg = nM * nN; G = G_; c = c_; npass = 1; pms = 0; pns = 0; }
    DI void passes(int np, int pms_, int pns_) { npass = np; pms = pms_; pns = pns_; }
    DI bool next(int i_, Unit& u) const {
        const int i = (npass == 1) ? i_ : i_ / npass, b = i_ - i * npass;
        const long L = (long)i * G + c; if (L >= nwg) return false;
        int wgid = (int)L; { const int q = nwg / NXCD, r = nwg % NXCD, xcd = wgid % NXCD, off = wgid / NXCD; wgid = (xcd < r ? xcd * (q + 1) : r * (q + 1) + (xcd - r) * q) + off; }
        const int nig = WGM * nN, gid = wgid / nig, fm = gid * WGM, gsz = (nM - fm) < WGM ? (nM - fm) : WGM;
        u.pm = fm + ((wgid % nig) % gsz) + b * pms; u.pn = (wgid % nig) / gsz + b * pns; return true;
    }
};


template <class Epi, bool HALFM = false>
DI void gemm_phase(LAS unsigned char* lds, const Gemm g, const StaticOrder& S, const Epi& E) {
    const int tid = ltid(), wid = __builtin_amdgcn_readfirstlane(tid >> 6), lane = tid & 63, wr = wid >> 2, wc = wid & 3, fr = lane & 15, fq = lane >> 4;
    const int K = g.K, nt = K / BK;
    unsigned voffA[2], voffB[2];
#pragma unroll
    for (int i = 0; i < 2; ++i) { int R, C; stage_rc(tid * 16 + i * 8192, R, C); const int Rb = (R & ~31) + perm32(R & 31);
        voffA[i] = (unsigned)(R * g.lda + C) * 2u; voffB[i] = (unsigned)(Rb * g.ldb + C) * 2u; }
    const size_t kstep = (size_t)(BK * 2);
    const size_t hstepA = (size_t)HALF * g.lda * 2, hstepB = (size_t)HALF * g.ldb * 2;
    const size_t tstepA = HALFM ? hstepA : 2 * hstepA, tstepB = 2 * hstepB;
    const unsigned ldsw = (unsigned)wid * 1024u;
    const int aoff = lds_byte(wr * 64 + fr, fq * 8), boff = lds_byte(wc * 32 + fr, fq * 8);
#define PG8_SA(b, h) (((b) * 2 + (h)) * HTB)
#define PG8_SB(b, h) ((4 + (b) * 2 + (h)) * HTB)
#define PG8_STAGE(bufoff, gbase, voff) do { _Pragma("unroll") for (int _i = 0; _i < 2; ++_i) \
        __builtin_amdgcn_global_load_lds((const unsigned*)((const char*)(gbase) + (voff)[_i]), (LAS unsigned*)(lds + (bufoff) + ldsw + _i * 8192), 16, 0, 0); } while (0)
#define PG8_LDA(dst, b, h) do { _Pragma("unroll") for (int m = 0; m < 4; ++m) _Pragma("unroll") for (int k = 0; k < 2; ++k) dst[m][k] = *(const LAS bf16x8*)(lds + PG8_SA(b, h) + aoff + m * 2048 + k * 1024); } while (0)
#define PG8_LDB(dst, b, h) do { _Pragma("unroll") for (int n = 0; n < 2; ++n) _Pragma("unroll") for (int k = 0; k < 2; ++k) dst[n][k] = *(const LAS bf16x8*)(lds + PG8_SB(b, h) + boff + n * 2048 + k * 1024); } while (0)
#define PG8_MMA(ai, bj, At, Bt) do { __builtin_amdgcn_s_setprio(1); _Pragma("unroll") for (int m = 0; m < 4; ++m) _Pragma("unroll") for (int n = 0; n < 2; ++n) _Pragma("unroll") for (int k = 0; k < 2; ++k) \
        acc[ai][bj][m][n] = __builtin_amdgcn_mfma_f32_16x16x32_bf16(Bt[n][k], At[m][k], acc[ai][bj][m][n], 0, 0, 0); __builtin_amdgcn_s_setprio(0); } while (0)
#define PG8_WAIT_V(n) asm volatile("s_waitcnt vmcnt(" #n ")" ::: "memory")
#define PG8_WAIT_L(n) asm volatile("s_waitcnt lgkmcnt(" #n ")" ::: "memory")
#define PG8_BAR __builtin_amdgcn_s_barrier()
#define PG8_SCHED __builtin_amdgcn_sched_barrier(0)
    Unit cur, nxt; int ui = 0;
    if (!S.next(0, cur)) return;
    f32x4 acc[2][2][4][2];
#pragma unroll
    for (int a = 0; a < 2; ++a)
#pragma unroll
        for (int b = 0; b < 2; ++b)
#pragma unroll
            for (int m = 0; m < 4; ++m)
#pragma unroll
                for (int n = 0; n < 2; ++n) acc[a][b][m][n] = (f32x4){0.f, 0.f, 0.f, 0.f};
    bf16x8 At[4][2], B0[2][2], B1[2][2];
    const char* cA = (const char*)g.A + (size_t)cur.pm * tstepA; const char* cB = (const char*)g.Bt + (size_t)cur.pn * tstepB;
    PG8_STAGE(PG8_SB(0, 0), cB, voffB); PG8_STAGE(PG8_SB(0, 1), cB + hstepB, voffB); PG8_STAGE(PG8_SA(0, 0), cA, voffA); PG8_STAGE(PG8_SA(0, 1), cA + hstepA, voffA);
    if (wr == 1) PG8_BAR;
    PG8_WAIT_V(2); PG8_BAR;
    PG8_STAGE(PG8_SB(1, 0), cB + kstep, voffB); PG8_STAGE(PG8_SA(1, 0), cA + kstep, voffA); PG8_STAGE(PG8_SB(1, 1), cB + hstepB + kstep, voffB);
    PG8_WAIT_V(6); PG8_BAR;
    for (;;) {
        const bool has_next = S.next(ui + 1, nxt);
        const char* nA = has_next ? (const char*)g.A + (size_t)nxt.pm * tstepA : cA; const char* nB = has_next ? (const char*)g.Bt + (size_t)nxt.pn * tstepB : cB;
#pragma unroll 1
        for (int t = 0; t < nt; t += 2) {
            const bool last = (t == nt - 2);
            const char* a1 = cA + (size_t)(t + 1) * kstep;
            const char* a2 = last ? nA : cA + (size_t)(t + 2) * kstep; const char* b2 = last ? nB : cB + (size_t)(t + 2) * kstep;
            const char* a3 = a2 + kstep; const char* b3 = b2 + kstep;
            PG8_LDB(B0, 0, 0); PG8_LDB(B1, 0, 1); PG8_SCHED; PG8_LDA(At, 0, 0); PG8_STAGE(PG8_SA(1, 1), a1 + hstepA, voffA);
            PG8_WAIT_V(8); PG8_WAIT_L(0); PG8_BAR; PG8_MMA(0, 0, At, B0); PG8_MMA(0, 1, At, B1); PG8_BAR; PG8_SCHED;
            if constexpr (!HALFM) PG8_LDA(At, 0, 1);
            PG8_STAGE(PG8_SB(0, 0), b2, voffB); PG8_STAGE(PG8_SB(0, 1), b2 + hstepB, voffB); PG8_STAGE(PG8_SA(0, 0), a2, voffA);
            PG8_WAIT_V(8); PG8_WAIT_L(0); PG8_BAR; if constexpr (!HALFM) { PG8_MMA(1, 0, At, B0); PG8_MMA(1, 1, At, B1); } PG8_BAR; PG8_SCHED;
            PG8_LDB(B0, 1, 0); PG8_LDB(B1, 1, 1); PG8_SCHED; PG8_LDA(At, 1, 0); PG8_STAGE(PG8_SA(0, 1), a2 + hstepA, voffA);
            PG8_WAIT_V(8); PG8_WAIT_L(0); PG8_BAR; PG8_MMA(0, 0, At, B0); PG8_MMA(0, 1, At, B1); PG8_BAR; PG8_SCHED;
            if constexpr (!HALFM) PG8_LDA(At, 1, 1);
            PG8_STAGE(PG8_SB(1, 0), b3, voffB); PG8_STAGE(PG8_SB(1, 1), b3 + hstepB, voffB); PG8_STAGE(PG8_SA(1, 0), a3, voffA);
            PG8_WAIT_V(8); PG8_WAIT_L(0); PG8_BAR; if constexpr (!HALFM) { PG8_MMA(1, 0, At, B0); PG8_MMA(1, 1, At, B1); } PG8_BAR; PG8_SCHED;
        }
        if (wr == 0) PG8_BAR;
        { const int l2 = ltid() & 63; E(acc, cur, wr, wc, l2 & 15, l2 >> 4); }
        if (!has_next) break;
#pragma unroll
        for (int a = 0; a < (HALFM ? 1 : 2); ++a)
#pragma unroll
            for (int b = 0; b < 2; ++b)
#pragma unroll
                for (int m = 0; m < 4; ++m)
#pragma unroll
                    for (int n = 0; n < 2; ++n) acc[a][b][m][n] = (f32x4){0.f, 0.f, 0.f, 0.f};
        cur = nxt; cA = nA; cB = nB; ++ui;
        if (wr == 1) PG8_BAR;
    }
    PG8_WAIT_V(0);
    PG8_BAR;
#undef PG8_SA
#undef PG8_SB
#undef PG8_STAGE
#undef PG8_LDA
#undef PG8_LDB
#undef PG8_MMA
#undef PG8_WAIT_V
#undef PG8_WAIT_L
#undef PG8_BAR
#undef PG8_SCHED
}

template <int MODE> struct EpiScaled {
    bf16_t* O; int ldc; const float* ss; float inv_dim; float* ss_cq; float* ss_ckv; const float* rope;
    DI void operator()(const f32x4 (&acc)[2][2][4][2], const Unit& u, int wr, int wc, int fr, int fq) const {
        const int row0 = u.pm * BM + wr * 64 + fr, col0 = u.pn * BM + wc * 32 + 8 * fq;
        float ssv[2][4];
#pragma unroll
        for (int ai = 0; ai < 2; ++ai)
#pragma unroll
            for (int m = 0; m < 4; ++m) ssv[ai][m] = ss ? ss[row0 + ai * HALF + m * 16] : 0.f;
#pragma unroll
        for (int ai = 0; ai < 2; ++ai)
#pragma unroll
            for (int m = 0; m < 4; ++m) {
                const int r = row0 + ai * HALF + m * 16;
                const float rs = ss ? __builtin_amdgcn_rsqf(ssv[ai][m] * inv_dim + EPS) : 1.f;
#pragma unroll
                for (int bj = 0; bj < 2; ++bj) {
                    float v[8];
#pragma unroll
                    for (int j = 0; j < 4; ++j) { v[j] = acc[ai][bj][m][0][j] * rs; v[4 + j] = acc[ai][bj][m][1][j] * rs; }
                    bool do_rope = false;
                    if (MODE == 1) {
                        const bool cq = (u.pn == 6) || (u.pn == 7 && bj == 0), ckv = (u.pn == 7 && bj == 1);
                        if (cq || ckv) {
                            float q = 0.f;
#pragma unroll
                            for (int j = 0; j < 8; ++j) q += v[j] * v[j];
                            q += __shfl_xor(q, 16); q += __shfl_xor(q, 32);
                            if (fq == 0) unsafeAtomicAdd((cq ? ss_cq : ss_ckv) + r, q);
                        }
                        do_rope = (u.pn == 8 && bj == 0 && wc == 0);
                    }
                    if (MODE == 2) { const int g32 = (u.pn * BM + bj * HALF + wc * 32) >> 5; do_rope = (g32 % 3) == 2; }
                    if (MODE != 0 && do_rope) {
                        const int pos = r & (SEQ - 1);
                        const f32x4* cs = (const f32x4*)(rope + ((size_t)pos * 16 + 8 * (fq & 1)) * 2);
#pragma unroll
                        for (int jj = 0; jj < 4; ++jj) {
                            const f32x4 c4 = cs[jj];
                            const float p0 = __shfl_xor(v[2 * jj], 32), p1 = __shfl_xor(v[2 * jj + 1], 32);
                            if (fq < 2) { v[2 * jj] = v[2 * jj] * c4[0] - p0 * c4[1]; v[2 * jj + 1] = v[2 * jj + 1] * c4[2] - p1 * c4[3]; }
                            else        { v[2 * jj] = p0 * c4[1] + v[2 * jj] * c4[0]; v[2 * jj + 1] = p1 * c4[3] + v[2 * jj + 1] * c4[2]; }
                        }
                    }
                    u32x4 w; w.x = pk2(v[0], v[1]); w.y = pk2(v[2], v[3]); w.z = pk2(v[4], v[5]); w.w = pk2(v[6], v[7]);
                    *(u32x4*)(O + (size_t)r * ldc + col0 + bj * HALF) = w;
                }
                asm volatile("" ::: "memory");
            }
    }
};

struct EpiSwiglu {
    bf16_t* O; int ldc; const float* ss;
    DI void operator()(const f32x4 (&acc)[2][2][4][2], const Unit& u, int wr, int wc, int fr, int fq) const {
        const int row0 = u.pm * BM + wr * 64 + fr, col0 = u.pn * 128 + wc * 32 + 8 * fq;
        float ssv[2][4];
#pragma unroll
        for (int ai = 0; ai < 2; ++ai)
#pragma unroll
            for (int m = 0; m < 4; ++m) ssv[ai][m] = ss[row0 + ai * HALF + m * 16];
#pragma unroll
        for (int ai = 0; ai < 2; ++ai)
#pragma unroll
            for (int m = 0; m < 4; ++m) {
                const int r = row0 + ai * HALF + m * 16;
                const float rs = __builtin_amdgcn_rsqf(ssv[ai][m] * (1.0f / 1024.0f) + EPS);
                float o[8];
#pragma unroll
                for (int n = 0; n < 2; ++n)
#pragma unroll
                    for (int e = 0; e < 4; ++e) { const float gg = acc[ai][0][m][n][e] * rs, uu = acc[ai][1][m][n][e] * rs; o[4 * n + e] = gg * sigmoidf_(gg) * uu; }
                u32x4 w; w.x = pk2(o[0], o[1]); w.y = pk2(o[2], o[3]); w.z = pk2(o[4], o[5]); w.w = pk2(o[6], o[7]);
                *(u32x4*)(O + (size_t)r * ldc + col0) = w;
                asm volatile("" ::: "memory");
            }
    }
};

struct EpiResid {
    const float* hin; float* hout; bf16_t* hb; float* ss_out; float scale;
    DI void operator()(const f32x4 (&acc)[2][2][4][2], const Unit& u, int wr, int wc, int fr, int fq) const {
        const int row0 = u.pm * BM + wr * 64 + fr, col0 = u.pn * BM + wc * 32 + 8 * fq;
        f32x4 hn[4][2][2];
#pragma unroll
        for (int g = 0; g < 4; ++g)
#pragma unroll
            for (int bj = 0; bj < 2; ++bj) { const size_t off = (size_t)(row0 + g * 16) * DM + col0 + bj * HALF; hn[g][bj][0] = *(const f32x4*)(hin + off); hn[g][bj][1] = *(const f32x4*)(hin + off + 4); }
#pragma unroll
        for (int ai = 0; ai < 2; ++ai)
#pragma unroll
            for (int m = 0; m < 4; ++m) {
                const int r = row0 + ai * HALF + m * 16;
                f32x4 hc[2][2];
#pragma unroll
                for (int bj = 0; bj < 2; ++bj) { hc[bj][0] = hn[m][bj][0]; hc[bj][1] = hn[m][bj][1]; }
                if (ai == 0) {
                    const int rn = row0 + HALF + m * 16;
#pragma unroll
                    for (int bj = 0; bj < 2; ++bj) { const size_t off = (size_t)rn * DM + col0 + bj * HALF; hn[m][bj][0] = *(const f32x4*)(hin + off); hn[m][bj][1] = *(const f32x4*)(hin + off + 4); }
                }
                float q = 0.f;
#pragma unroll
                for (int bj = 0; bj < 2; ++bj) {
                    const size_t off = (size_t)r * DM + col0 + bj * HALF;
                    f32x4 h0 = hc[bj][0], h1 = hc[bj][1];
                    h0 += acc[ai][bj][m][0] * scale; h1 += acc[ai][bj][m][1] * scale;
                    *(f32x4*)(hout + off) = h0; *(f32x4*)(hout + off + 4) = h1;
                    u32x4 w; w.x = pk2(h0[0], h0[1]); w.y = pk2(h0[2], h0[3]); w.z = pk2(h1[0], h1[1]); w.w = pk2(h1[2], h1[3]);
                    if (hb) *(u32x4*)(hb + off) = w;
                    q += h0[0] * h0[0] + h0[1] * h0[1] + h0[2] * h0[2] + h0[3] * h0[3] + h1[0] * h1[0] + h1[1] * h1[1] + h1[2] * h1[2] + h1[3] * h1[3];
                }
                q += __shfl_xor(q, 16); q += __shfl_xor(q, 32);
                if (fq == 0) unsafeAtomicAdd(ss_out + r, q);
                asm volatile("" ::: "memory");
            }
    }
};

struct EpiGate {
    const bf16_t* gate0; int ldg; const float* bias0; float* m32; bf16_t* mb;
    DI void operator()(f32x4 (&acc)[2][2][4][2], const Unit& u, int wr, int wc, int fr, int fq) const {
        const int b = u.pm / (TC / HALF), pm = u.pm - b * (TC / HALF), pn = u.pn - b * 4;
        const bool first = (b == 0), last = (b == 2);
        const bf16_t* gate = gate0 + b * 1024; const float* bias = bias0 + b * 1024;
        const int row0 = pm * HALF + wr * 64 + fr, col0 = pn * BM + wc * 32 + 8 * fq;
        f32x4 bz[2][2]; u32x4 gall[4][2];
#pragma unroll
        for (int bj = 0; bj < 2; ++bj) { bz[bj][0] = *(const f32x4*)(bias + col0 + bj * HALF); bz[bj][1] = *(const f32x4*)(bias + col0 + bj * HALF + 4); }
#pragma unroll
        for (int m = 0; m < 4; ++m)
#pragma unroll
            for (int bj = 0; bj < 2; ++bj) gall[m][bj] = *(const u32x4*)(gate + (size_t)(row0 + m * 16) * ldg + col0 + bj * HALF);
#pragma unroll
        for (int ai = 0; ai < 1; ++ai)
#pragma unroll
            for (int m = 0; m < 4; ++m) {
                const int r = row0 + ai * HALF + m * 16;
#pragma unroll
                for (int bj = 0; bj < 2; ++bj) {
                    const int c = col0 + bj * HALF;
                    const u32x4 gw = gall[m][bj];
                    const f32x4 b0 = bz[bj][0], b1 = bz[bj][1];
                    f32x4 v0, v1;
                    v0[0] = acc[ai][bj][m][0][0] * sigmoidf_(bflo(gw.x) + b0[0]); v0[1] = acc[ai][bj][m][0][1] * sigmoidf_(bfhi(gw.x) + b0[1]);
                    v0[2] = acc[ai][bj][m][0][2] * sigmoidf_(bflo(gw.y) + b0[2]); v0[3] = acc[ai][bj][m][0][3] * sigmoidf_(bfhi(gw.y) + b0[3]);
                    v1[0] = acc[ai][bj][m][1][0] * sigmoidf_(bflo(gw.z) + b1[0]); v1[1] = acc[ai][bj][m][1][1] * sigmoidf_(bfhi(gw.z) + b1[1]);
                    v1[2] = acc[ai][bj][m][1][2] * sigmoidf_(bflo(gw.w) + b1[2]); v1[3] = acc[ai][bj][m][1][3] * sigmoidf_(bfhi(gw.w) + b1[3]);
                    const size_t off = (size_t)r * DM + c;
                    if (!first) { v0 += acc[1][bj][m][0]; v1 += acc[1][bj][m][1]; }
                    if (!last) { acc[1][bj][m][0] = v0; acc[1][bj][m][1] = v1; }
                    else { u32x4 w; w.x = pk2(v0[0], v0[1]); w.y = pk2(v0[2], v0[3]); w.z = pk2(v1[0], v1[1]); w.w = pk2(v1[2], v1[3]); *(u32x4*)(mb + off) = w; }
                    asm volatile("" ::: "memory");
                }
            }
    }
};
}

struct AttnArgs {
    const bf16_t* Q; int ldq;
    const bf16_t* K; int ldk;
    const bf16_t* K2; int ldk2;
    const bf16_t* V; int ldv;
    bf16_t* O; int ldo;
    float* lse; int ldl;
    int q0, tstride, toff, nk;
    float c2;
    const float* biasg;
};
DI int crow(int i, int hh) { return (i & 3) + 8 * (i >> 2) + 4 * hh; }
#define MFMA32(a, b, c) __builtin_amdgcn_mfma_f32_32x32x16_bf16((a), (b), (c), 0, 0, 0)

template <int MODE> struct ACfg;
template <> struct ACfg<0> { static constexpr int DK = 128, DV = 128; };
template <> struct ACfg<1> { static constexpr int DK = 96, DV = 64; };
template <> struct ACfg<2> { static constexpr int DK = 64, DV = 64; };
template <> struct ACfg<3> { static constexpr int DK = 64, DV = 64; };

DI bf16x8 pack8(const f32x16& x, int s) {
    u32x4 p;
    p.x = pk2(x[8 * s + 0], x[8 * s + 1]); p.y = pk2(x[8 * s + 2], x[8 * s + 3]); p.z = pk2(x[8 * s + 4], x[8 * s + 5]); p.w = pk2(x[8 * s + 6], x[8 * s + 7]);
    return __builtin_bit_cast(bf16x8, p);
}

template <bool MASKED>
DI void sb_block(f32x16& s, int kb0, int qi, int hh, float c2, float& carry) {
    float kp[16], bt[16];
#pragma unroll
    for (int i = 0; i < 16; ++i) {
        const float t = ex2(-fabsf(s[i]) * c2);
        const float r = __builtin_amdgcn_rcpf(1.0f + t), tr = t * r;
        const bool pos = s[i] >= 0.f;
        float b = pos ? r : tr, k = pos ? tr : r;
        if (MASKED) { const bool valid = (kb0 + crow(i, hh)) < qi; b = valid ? b : 0.f; k = valid ? k : 1.f; }
        bt[i] = b; kp[i] = k;
    }
    float gs[4], pg[4];
#pragma unroll
    for (int q = 0; q < 4; ++q) gs[q] = (kp[4 * q] * kp[4 * q + 1]) * (kp[4 * q + 2] * kp[4 * q + 3]);
#pragma unroll
    for (int q = 0; q < 4; ++q) pg[q] = __shfl_xor(gs[q], 32);
    float run = carry;
#pragma unroll
    for (int q = 3; q >= 0; --q) {
        const float a3 = (hh == 0) ? run * pg[q] : run;
        const float a2 = a3 * kp[4 * q + 3], a1 = a2 * kp[4 * q + 2], a0 = a1 * kp[4 * q + 1];
        s[4 * q + 0] = bt[4 * q + 0] * a0; s[4 * q + 1] = bt[4 * q + 1] * a1; s[4 * q + 2] = bt[4 * q + 2] * a2; s[4 * q + 3] = bt[4 * q + 3] * a3;
        run *= gs[q] * pg[q];
    }
    carry = run;
}

template <int MODE>
DI void attn_unit(LAS unsigned char* lds, const AttnArgs a) {
    constexpr int DK = ACfg<MODE>::DK, DV = ACfg<MODE>::DV, KLD = DK + 8, VLD = 72, NKS = DK / 16, NDB = DV / 32;
    const int tid = ltid(), wid = __builtin_amdgcn_readfirstlane(tid >> 6), lane = tid & 63, r32 = lane & 31, hh = lane >> 5;
    constexpr bool SWZ = (DV == 64);
    constexpr int BUFE = 64 * KLD + DV * VLD;
    LAS bf16_t* Ks = (LAS bf16_t*)lds;
    LAS bf16_t* Vt = Ks + 64 * KLD;
    LAS float* biasL = (LAS float*)(Ks + 2 * BUFE);
    const int q0w = a.q0 + wid * 32, qi = q0w + r32;
    const size_t qtok = (size_t)a.toff + (size_t)qi * a.tstride;
    bf16x8 qf[NKS];
#pragma unroll
    for (int ks = 0; ks < NKS; ++ks) qf[ks] = *(const bf16x8*)(a.Q + qtok * a.ldq + ks * 16 + 8 * hh);
    if (MODE == 3) { __syncthreads(); if (tid < 129) biasL[tid] = a.biasg[tid]; }
    f32x16 o[NDB];
#pragma unroll
    for (int d = 0; d < NDB; ++d)
#pragma unroll
        for (int i = 0; i < 16; ++i) o[d][i] = 0.f;
    float mrow = -1e30f, lrow = 0.f, carry = 1.f;
    int ntile;
    if (MODE == 0) ntile = a.nk / 64; else if (MODE == 1) ntile = (a.q0 + 255) / 64 + 1; else if (MODE == 2) ntile = (a.q0 + 254) / 64 + 1; else ntile = 6;
    const int it0 = (MODE == 3 && a.q0 == 0) ? 2 : 0;
    constexpr int NKC = (64 * (DK / 8) + 511) / 512, NVC = (64 * (DV / 8) + 511) / 512;
    u32x4 kreg[NKC], vreg[NVC];
#define ATT_KBASE(it_) ((MODE == 2) ? (ntile - 1 - (it_)) * 64 : ((MODE == 3) ? a.q0 - 128 + (it_) * 64 : (it_) * 64))
#define ATT_LOAD(it_) do { const int kb_ = ATT_KBASE(it_); \
        _Pragma("unroll") for (int i_ = 0; i_ < NKC; ++i_) { const int c = tid + i_ * 512; if (c < 64 * (DK / 8)) { \
            const int row = c / (DK / 8), ch = c % (DK / 8); int kj = kb_ + row; if (MODE == 3) kj = kj < 0 ? 0 : kj; \
            const size_t tok = (size_t)a.toff + (size_t)kj * a.tstride; \
            const bf16_t* src = (MODE == 1 && ch >= 8) ? (a.K2 + tok * a.ldk2 + (ch - 8) * 8) : (a.K + tok * a.ldk + ch * 8); \
            kreg[i_] = *(const u32x4*)src; } } \
        _Pragma("unroll") for (int i_ = 0; i_ < NVC; ++i_) { const int c = tid + i_ * 512; \
            const int row = c / (DV / 8), ch = c % (DV / 8); int kj = kb_ + row; if (MODE == 3) kj = kj < 0 ? 0 : kj; \
            const size_t tok = (size_t)a.toff + (size_t)kj * a.tstride; \
            vreg[i_] = *(const u32x4*)(a.V + tok * a.ldv + ch * 8); } } while (0)
#define ATT_STORE(b_) do { LAS bf16_t* Kd = Ks + (b_) * BUFE; LAS bf16_t* Vd = Vt + (b_) * BUFE; \
        _Pragma("unroll") for (int i_ = 0; i_ < NKC; ++i_) { const int c = tid + i_ * 512; if (c < 64 * (DK / 8)) { const int row = c / (DK / 8), ch = c % (DK / 8); *(LAS u32x4*)(Kd + row * KLD + ch * 8) = kreg[i_]; } } \
        _Pragma("unroll") for (int i_ = 0; i_ < NVC; ++i_) { \
            const int c = tid + i_ * 512, row = c / (DV / 8), ch = c % (DV / 8); \
            const u32x4 v = vreg[i_]; \
            LAS bf16_t* dst = Vd + (ch * 8) * VLD + (row ^ (SWZ ? ((ch & 7) << 2) : 0));   \
            dst[0 * VLD] = (bf16_t)(v.x & 0xffff); dst[1 * VLD] = (bf16_t)(v.x >> 16); \
            dst[2 * VLD] = (bf16_t)(v.y & 0xffff); dst[3 * VLD] = (bf16_t)(v.y >> 16); \
            dst[4 * VLD] = (bf16_t)(v.z & 0xffff); dst[5 * VLD] = (bf16_t)(v.z >> 16); \
            dst[6 * VLD] = (bf16_t)(v.w & 0xffff); dst[7 * VLD] = (bf16_t)(v.w >> 16); } } while (0)
    ATT_LOAD(it0);
    ATT_STORE(0);
    __syncthreads();
    if (it0 + 1 < ntile) ATT_LOAD(it0 + 1);
    bool sb_dead = false;
    for (int it = it0; it < ntile; ++it) {
        const int kbase = ATT_KBASE(it), cur = (it - it0) & 1;
        const LAS bf16_t* Kc = Ks + cur * BUFE; const LAS bf16_t* Vc = Vt + cur * BUFE;
        bool active = true;
        if (MODE == 1) active = kbase <= q0w + 31;
        if (MODE == 2) active = (kbase <= q0w + 30) && !sb_dead;
        if (MODE == 3) active = (kbase + 63 >= q0w - 128) && (kbase <= q0w + 31);
        if (active) {
        f32x16 s0, s1;
#pragma unroll
        for (int i = 0; i < 16; ++i) { s0[i] = 0.f; s1[i] = 0.f; }
#pragma unroll
        for (int ks = 0; ks < NKS; ++ks) {
            const bf16x8 a0 = *(const LAS bf16x8*)(Kc + r32 * KLD + ks * 16 + 8 * hh);
            const bf16x8 a1 = *(const LAS bf16x8*)(Kc + (32 + r32) * KLD + ks * 16 + 8 * hh);
            s0 = MFMA32(a0, qf[ks], s0); s1 = MFMA32(a1, qf[ks], s1);
        }
        if (MODE == 2) {
            if (kbase + 63 < q0w) { sb_block<false>(s1, kbase + 32, qi, hh, a.c2, carry); sb_block<false>(s0, kbase, qi, hh, a.c2, carry); }
            else                  { sb_block<true>(s1, kbase + 32, qi, hh, a.c2, carry);  sb_block<true>(s0, kbase, qi, hh, a.c2, carry); }
        } else {
            const bool interior = (MODE == 0) || (MODE == 1 && kbase + 63 <= q0w);
            float mnew, alpha, ls = 0.f;
            if (interior) {
#pragma unroll
                for (int i = 0; i < 16; ++i) { s0[i] *= a.c2; s1[i] *= a.c2; }
                float mx = max3f(s0[0], s1[0], s0[1]);
                mx = max3f(mx, s1[1], s0[2]); mx = max3f(mx, s1[2], s0[3]); mx = max3f(mx, s1[3], s0[4]); mx = max3f(mx, s1[4], s0[5]);
                mx = max3f(mx, s1[5], s0[6]); mx = max3f(mx, s1[6], s0[7]); mx = max3f(mx, s1[7], s0[8]); mx = max3f(mx, s1[8], s0[9]);
                mx = max3f(mx, s1[9], s0[10]); mx = max3f(mx, s1[10], s0[11]); mx = max3f(mx, s1[11], s0[12]); mx = max3f(mx, s1[12], s0[13]);
                mx = max3f(mx, s1[13], s0[14]); mx = max3f(mx, s1[14], s0[15]); mx = fmaxf(mx, s1[15]);
                mx = fmaxf(mx, __shfl_xor(mx, 32));
                mnew = fmaxf(mrow, mx); alpha = ex2(mrow - mnew);
#pragma unroll
                for (int i = 0; i < 16; ++i) {
                    const float p0 = ex2(s0[i] - mnew), p1 = ex2(s1[i] - mnew);
                    s0[i] = p0; s1[i] = p1; ls += p0 + p1;
                }
            } else {
                float mx = -1e30f;
#pragma unroll
                for (int i = 0; i < 16; ++i) {
                    const int k0 = kbase + crow(i, hh), k1 = k0 + 32;
                    float x0 = s0[i] * a.c2, x1 = s1[i] * a.c2;
                    bool v0 = true, v1 = true;
                    if (MODE == 1) { v0 = k0 <= qi; v1 = k1 <= qi; }
                    if (MODE == 3) {
                        const int st0 = qi - k0, st1 = qi - k1;
                        v0 = (st0 >= 0) && (st0 <= 128) && (k0 >= 0); v1 = (st1 >= 0) && (st1 <= 128) && (k1 >= 0);
                        x0 += biasL[min(max(st0, 0), 128)]; x1 += biasL[min(max(st1, 0), 128)];
                    }
                    x0 = v0 ? x0 : -1e30f; x1 = v1 ? x1 : -1e30f;
                    s0[i] = x0; s1[i] = x1; mx = fmaxf(mx, fmaxf(x0, x1));
                }
                mx = fmaxf(mx, __shfl_xor(mx, 32));
                mnew = fmaxf(mrow, mx); alpha = ex2(mrow - mnew);
#pragma unroll
                for (int i = 0; i < 16; ++i) {
                    const float p0 = (s0[i] > -1e29f) ? ex2(s0[i] - mnew) : 0.f, p1 = (s1[i] > -1e29f) ? ex2(s1[i] - mnew) : 0.f;
                    s0[i] = p0; s1[i] = p1; ls += p0 + p1;
                }
            }
            mrow = mnew;
            lrow = lrow * alpha + ls;
            if (__ballot(alpha < 1.0f) != 0ull) {
#pragma unroll
                for (int d = 0; d < NDB; ++d)
#pragma unroll
                    for (int i = 0; i < 16; ++i) o[d][i] *= alpha;
            }
        }
        const bf16x8 pb00 = pack8(s0, 0), pb01 = pack8(s0, 1), pb10 = pack8(s1, 0), pb11 = pack8(s1, 1);
#pragma unroll
        for (int d = 0; d < NDB; ++d) {
            const LAS bf16_t* vp = Vc + (d * 32 + r32) * VLD;
            const int sw = SWZ ? ((((d * 32 + r32) >> 3) & 7) << 2) : 0;
#define VFRAG(off) __builtin_shufflevector(*(const LAS s16x4*)(vp + (((off) + 4 * hh) ^ sw)), *(const LAS s16x4*)(vp + (((off) + 8 + 4 * hh) ^ sw)), 0, 1, 2, 3, 4, 5, 6, 7)
            o[d] = MFMA32(VFRAG(0), pb00, o[d]);
            o[d] = MFMA32(VFRAG(16), pb01, o[d]);
            o[d] = MFMA32(VFRAG(32), pb10, o[d]);
            o[d] = MFMA32(VFRAG(48), pb11, o[d]);
#undef VFRAG
        }
        }
        if (it + 1 < ntile) ATT_STORE(cur ^ 1);
        if (MODE == 2) {
            sb_dead = (__ballot(carry != 0.f) == 0ull);
            if (!__syncthreads_or(sb_dead ? 0 : 1)) break;
        } else __syncthreads();
        if (it + 2 < ntile) ATT_LOAD(it + 2);
    }
    float inv = 1.f;
    if (MODE != 2) {
        const float lt = lrow + __shfl_xor(lrow, 32);
        inv = 1.0f / lt;
        if (MODE == 3 && hh == 0) a.lse[qtok * a.ldl] = mrow + lg2(lt);
    }
#pragma unroll
    for (int d = 0; d < NDB; ++d)
#pragma unroll
        for (int g4 = 0; g4 < 4; ++g4) {
            u32x2 w; w.x = pk2(o[d][4 * g4] * inv, o[d][4 * g4 + 1] * inv); w.y = pk2(o[d][4 * g4 + 2] * inv, o[d][4 * g4 + 3] * inv);
            *(u32x2*)(a.O + qtok * a.ldo + d * 32 + 8 * g4 + 4 * hh) = w;
        }
}

DI void attn_dil_unit(LAS unsigned char* lds, const AttnArgs a) {
    constexpr int KLD = 72, VLD = 392, NK = 384;
    const int tid = ltid(), wid = __builtin_amdgcn_readfirstlane(tid >> 6), lane = tid & 63, r32 = lane & 31, hh = lane >> 5;
    LAS bf16_t* Kl = (LAS bf16_t*)lds;
    LAS bf16_t* Vl = Kl + NK * KLD;
    LAS float* biasL = (LAS float*)(Vl + 64 * VLD);
    const int q0w = a.q0 + wid * 32, qi = q0w + r32;
    const size_t qtok = (size_t)a.toff + (size_t)qi * a.tstride;
    bf16x8 qf[4];
#pragma unroll
    for (int ks = 0; ks < 4; ++ks) qf[ks] = *(const bf16x8*)(a.Q + qtok * a.ldq + ks * 16 + 8 * hh);
    {
        u32x4 kr[6], vr[6];
#pragma unroll
        for (int i = 0; i < 6; ++i) {
            const int c = tid + 512 * i, row = c >> 3, ch = c & 7;
            int kj = a.q0 - 128 + row; kj = kj < 0 ? 0 : kj;
            const size_t tok = (size_t)a.toff + (size_t)kj * a.tstride;
            kr[i] = *(const u32x4*)(a.K + tok * a.ldk + ch * 8);
            vr[i] = *(const u32x4*)(a.V + tok * a.ldv + ch * 8);
        }
        const float bv = (tid < 129) ? a.biasg[tid] : 0.f;
        __syncthreads();
        if (tid < 129) biasL[tid] = bv;
#pragma unroll
        for (int i = 0; i < 6; ++i) {
            const int c = tid + 512 * i, row = c >> 3, ch = c & 7;
            *(LAS u32x4*)(Kl + row * KLD + ch * 8) = kr[i];
            const u32x4 v = vr[i];
            LAS bf16_t* dst = Vl + (ch * 8) * VLD + (row ^ (ch << 2));
            dst[0 * VLD] = (bf16_t)(v.x & 0xffff); dst[1 * VLD] = (bf16_t)(v.x >> 16);
            dst[2 * VLD] = (bf16_t)(v.y & 0xffff); dst[3 * VLD] = (bf16_t)(v.y >> 16);
            dst[4 * VLD] = (bf16_t)(v.z & 0xffff); dst[5 * VLD] = (bf16_t)(v.z >> 16);
            dst[6 * VLD] = (bf16_t)(v.w & 0xffff); dst[7 * VLD] = (bf16_t)(v.w >> 16);
        }
    }
    __syncthreads();
    f32x16 sc[5];
#pragma unroll
    for (int j = 0; j < 5; ++j) {
#pragma unroll
        for (int i = 0; i < 16; ++i) sc[j][i] = 0.f;
#pragma unroll
        for (int ks = 0; ks < 4; ++ks) {
            const bf16x8 kf = *(const LAS bf16x8*)(Kl + (32 * wid + 32 * j + r32) * KLD + ks * 16 + 8 * hh);
            sc[j] = MFMA32(kf, qf[ks], sc[j]);
        }
    }
    float mx = -1e30f;
#pragma unroll
    for (int j = 0; j < 5; ++j)
#pragma unroll
        for (int i = 0; i < 16; ++i) {
            const int st = r32 + 128 - 32 * j - crow(i, hh);
            const int kj = qi - st;
            const bool valid = (st >= 0) && (st <= 128) && (kj >= 0);
            float x = sc[j][i] * a.c2 + biasL[min(max(st, 0), 128)];
            x = valid ? x : -1e30f;
            sc[j][i] = x; mx = fmaxf(mx, x);
        }
    mx = fmaxf(mx, __shfl_xor(mx, 32));
    float ls = 0.f;
#pragma unroll
    for (int j = 0; j < 5; ++j)
#pragma unroll
        for (int i = 0; i < 16; ++i) { const float p = (sc[j][i] > -1e29f) ? ex2(sc[j][i] - mx) : 0.f; sc[j][i] = p; ls += p; }
    const float lt = ls + __shfl_xor(ls, 32);
    f32x16 o[2];
#pragma unroll
    for (int d = 0; d < 2; ++d)
#pragma unroll
        for (int i = 0; i < 16; ++i) o[d][i] = 0.f;
#pragma unroll
    for (int j = 0; j < 5; ++j) {
        const bf16x8 pb0 = pack8(sc[j], 0), pb1 = pack8(sc[j], 1);
#pragma unroll
        for (int d = 0; d < 2; ++d) {
            const LAS bf16_t* vp = Vl + (d * 32 + r32) * VLD + 32 * wid + 32 * j;
            const int sw = (((d * 32 + r32) >> 3) & 7) << 2;
#define VFRAG2(off) __builtin_shufflevector(*(const LAS s16x4*)(vp + (((off) + 4 * hh) ^ sw)), *(const LAS s16x4*)(vp + (((off) + 8 + 4 * hh) ^ sw)), 0, 1, 2, 3, 4, 5, 6, 7)
            o[d] = MFMA32(VFRAG2(0), pb0, o[d]);
            o[d] = MFMA32(VFRAG2(16), pb1, o[d]);
#undef VFRAG2
        }
    }
    const float inv = 1.0f / lt;
    if (hh == 0) a.lse[qtok * a.ldl] = mx + lg2(lt);
#pragma unroll
    for (int d = 0; d < 2; ++d)
#pragma unroll
        for (int g4 = 0; g4 < 4; ++g4) {
            u32x2 w; w.x = pk2(o[d][4 * g4] * inv, o[d][4 * g4 + 1] * inv); w.y = pk2(o[d][4 * g4 + 2] * inv, o[d][4 * g4 + 3] * inv);
            *(u32x2*)(a.O + qtok * a.ldo + d * 32 + 8 * g4 + 4 * hh) = w;
        }
}

struct Params { const float* in[28]; float* out; unsigned char* ws; int ph_lo, ph_hi; };
typedef const __attribute__((address_space(4))) unsigned char* kptr_t;
#define KIN(i) (*(const float* const __attribute__((address_space(4)))*)(kb + 8 * (i)))
#define KOUT (*(float* const __attribute__((address_space(4)))*)(kb + 224))
#define KWS (*(unsigned char* const __attribute__((address_space(4)))*)(kb + 232))


DI float wave_sum(float v) {
#pragma unroll
    for (int o = 32; o >= 1; o >>= 1) v += __shfl_xor(v, o);
    return v;
}

struct WDesc { const float* s0; const float* s1; const float* gain; bf16_t* dst; int nrows, kdst, ksrc, ldsrc, map; };

DI int convert_weight(LAS unsigned char* lds, const WDesc d, int G, int bid, int goff) {
    LAS bf16_t* tl = (LAS bf16_t*)lds;
    const int tid = ltid();
    const int nkt = d.kdst / 64, ntile = (d.nrows / 64) * nkt;
    const int ngrp = (ntile + 3) >> 2;
    int g0 = (bid - goff) % G; if (g0 < 0) g0 += G;
    for (int t0 = g0 * 4; t0 < ntile; t0 += G * 4) {
        float v[4][8];
#pragma unroll
        for (int j = 0; j < 4; ++j) {
            const int t = t0 + j, tc = t / nkt, tk = t % nkt;
            const int cc = tid & 63, c = tc * 64 + cc;
            int col; const float* src = d.s0;
            if (d.map == 0) col = c;
            else if (d.map == 1) { col = (c >> 8) * 128 + (c & 127); if (c & 128) src = d.s1; }
            else { col = c < 2080 ? c : (c < 2304 ? -1 : c - 224); }
#pragma unroll
            for (int i = 0; i < 8; ++i) {
                const int kk = (tid >> 6) + 8 * i, k = tk * 64 + kk;
                float x = 0.f;
                if (t < ntile && col >= 0 && k < d.ksrc) { x = src[(size_t)k * d.ldsrc + col]; if (d.gain) x *= d.gain[k]; }
                v[j][i] = x;
            }
        }
        __syncthreads();
#pragma unroll
        for (int j = 0; j < 4; ++j)
#pragma unroll
            for (int i = 0; i < 8; ++i) tl[j * 64 * 66 + (tid & 63) * 66 + (tid >> 6) + 8 * i] = (bf16_t)(pk2(v[j][i], 0.f) & 0xffff);
        __syncthreads();
#pragma unroll
        for (int j = 0; j < 4; ++j) {
            const int t = t0 + j, tc = t / nkt, tk = t % nkt;
            const int rr = tid >> 3, kc = tid & 7;
            const LAS unsigned* sp = (const LAS unsigned*)(tl + j * 64 * 66 + rr * 66 + kc * 8);
            u32x4 w; w.x = sp[0]; w.y = sp[1]; w.z = sp[2]; w.w = sp[3];
            if (t < ntile) *(u32x4*)(d.dst + (size_t)(tc * 64 + rr) * d.kdst + tk * 64 + kc * 8) = w;
        }
    }
    return goff + ngrp;
}

DI WDesc wdesc(kptr_t kb, bf16_t* wl, int l, int id) {
    WDesc d; d.s1 = nullptr; d.gain = nullptr; d.map = 0;
    switch (id) {
    case 0: d.s0 = KIN(3) + (size_t)l * 1024 * 2816; d.s1 = KIN(4) + (size_t)l * 1024 * 2816; d.gain = KIN(2) + l * 1024; d.dst = wl + WO_GU1; d.nrows = 5632; d.kdst = 1024; d.ksrc = 1024; d.ldsrc = 2816; d.map = 1; break;
    case 1: d.s0 = KIN(5) + (size_t)l * 2816 * 1024; d.dst = wl + WO_D1; d.nrows = 1024; d.kdst = 2816; d.ksrc = 2816; d.ldsrc = 1024; break;
    case 2: d.s0 = KIN(7) + (size_t)l * 1024 * 9760; d.gain = KIN(6) + l * 1024; d.dst = wl + WO_IN; d.nrows = NINP; d.kdst = 1024; d.ksrc = 1024; d.ldsrc = 9760; d.map = 2; break;
    case 3: d.s0 = KIN(10) + (size_t)l * 384 * 768; d.gain = KIN(9) + l * 384; d.dst = wl + WO_UQ; d.nrows = 768; d.kdst = 384; d.ksrc = 384; d.ldsrc = 768; break;
    case 4: d.s0 = KIN(12) + (size_t)l * 128 * 1024; d.gain = KIN(11) + l * 128; d.dst = wl + WO_UKV; d.nrows = 1024; d.kdst = 256; d.ksrc = 128; d.ldsrc = 1024; break;
    case 5: d.s0 = KIN(13) + (size_t)l * 512 * 1024; d.dst = wl + WO_BA; d.nrows = 1024; d.kdst = 512; d.ksrc = 512; d.ldsrc = 1024; break;
    case 6: d.s0 = KIN(14) + (size_t)l * 512 * 1024; d.dst = wl + WO_BB; d.nrows = 1024; d.kdst = 512; d.ksrc = 512; d.ldsrc = 1024; break;
    case 7: d.s0 = KIN(15) + (size_t)l * 512 * 1024; d.dst = wl + WO_BC; d.nrows = 1024; d.kdst = 512; d.ksrc = 512; d.ldsrc = 1024; break;
    case 8: d.s0 = KIN(16) + (size_t)l * 1024 * 1024; d.dst = wl + WO_MO; d.nrows = 1024; d.kdst = 1024; d.ksrc = 1024; d.ldsrc = 1024; break;
    case 9: d.s0 = KIN(20) + (size_t)l * 1024 * 512; d.gain = KIN(18) + l * 1024; d.dst = wl + WO_XQ; d.nrows = 512; d.kdst = 1024; d.ksrc = 1024; d.ldsrc = 512; break;
    case 10: d.s0 = KIN(21) + (size_t)l * 1024 * 1024; d.gain = KIN(19) + l * 1024; d.dst = wl + WO_XKV; d.nrows = 1024; d.kdst = 1024; d.ksrc = 1024; d.ldsrc = 1024; break;
    case 11: d.s0 = KIN(22) + (size_t)l * 512 * 1024; d.dst = wl + WO_XO; d.nrows = 1024; d.kdst = 512; d.ksrc = 512; d.ldsrc = 1024; break;
    case 12: d.s0 = KIN(24) + (size_t)l * 1024 * 2816; d.s1 = KIN(25) + (size_t)l * 1024 * 2816; d.gain = KIN(23) + l * 1024; d.dst = wl + WO_GU2; d.nrows = 5632; d.kdst = 1024; d.ksrc = 1024; d.ldsrc = 2816; d.map = 1; break;
    default: d.s0 = KIN(26) + (size_t)l * 2816 * 1024; d.dst = wl + WO_D2; d.nrows = 1024; d.kdst = 2816; d.ksrc = 2816; d.ldsrc = 1024; break;
    }
    return d;
}

DI void rows_to_bf16(const float* src, bf16_t* dst, float* ss, int nrows, int gw, int nw) {
    const int lane = ltid() & 63;
    for (int r = gw; r < nrows; r += nw) {
        float q = 0.f;
#pragma unroll
        for (int i = 0; i < 4; ++i) {
            const f32x4 v = *(const f32x4*)(src + (size_t)r * 1024 + i * 256 + lane * 4);
            q += v[0] * v[0] + v[1] * v[1] + v[2] * v[2] + v[3] * v[3];
            u32x2 w; w.x = pk2(v[0], v[1]); w.y = pk2(v[2], v[3]);
            *(u32x2*)(dst + (size_t)r * 1024 + i * 256 + lane * 4) = w;
        }
        q = wave_sum(q);
        if (lane == 0) ss[r] = q;
    }
}


#define XB_TMO      128
#define XB_XCNT(j)  (256  + 64 * (j))
#define XB_XSUB(j)  (1280 + 64 * (j))
#define XB_XGEN(j)  (2304 + 64 * (j))
#define XB_TOP      3328
#define XB_TOPGEN   3392
#define XCD_BAR_WORDS 3456
#define XB_SPIN_CAP (1u << 20)
DI unsigned xb_ld(unsigned* p)              { return __hip_atomic_load(p, __ATOMIC_RELAXED, __HIP_MEMORY_SCOPE_AGENT); }
DI unsigned xb_add(unsigned* p, unsigned v) { return __hip_atomic_fetch_add(p, v, __ATOMIC_RELAXED, __HIP_MEMORY_SCOPE_AGENT); }
DI unsigned xb_xcc_id() { return (unsigned)__builtin_amdgcn_s_getreg((3 << 11) | 20) & 0xFu; }
#define XB_SPIN(cond, bar) do { unsigned _sp = 0; while (cond) { \
    if ((++_sp & 255u) == 0u) { if (xb_ld(&(bar)[XB_TMO])) break; if (_sp > XB_SPIN_CAP) { atomicAdd(&(bar)[XB_TMO], 1u); break; } } } } while (0)
DI void xcd_barrier_complete(unsigned* bar, unsigned x, unsigned& nloc, unsigned& nx) {
    const unsigned G = gridDim.x * gridDim.y * gridDim.z;
    unsigned sum, cnt, mine, sp = 0u;
    for (;;) {
        sum = 0u; cnt = 0u; mine = 0u;
#pragma unroll
        for (unsigned j = 0; j < 16; ++j) { const unsigned c = xb_ld(&bar[XB_XCNT(j)]); sum += c; cnt += (c > 0u) ? 1u : 0u; mine = (j == x) ? c : mine; }
        if (sum == G) break;
        __builtin_amdgcn_s_sleep(1);
        if ((++sp & 255u) == 0u) { if (xb_ld(&bar[XB_TMO])) break; if (sp > XB_SPIN_CAP) { atomicAdd(&bar[XB_TMO], 1u); break; } }
    }
    nloc = mine > 0u ? mine : 1u; nx = cnt > 0u ? cnt : 1u;
}
DI void xcd_barrier(unsigned* bar, volatile LAS unsigned* st) {
    asm volatile("s_waitcnt vmcnt(0)" ::: "memory");
    __syncthreads();
    if (threadIdx.x == 0) {
        const unsigned x = xb_xcc_id();
        __builtin_amdgcn_s_waitcnt(0);
        unsigned nloc = st[0], nx = st[1];
        if (nloc == 0u) { xcd_barrier_complete(bar, x, nloc, nx); st[0] = nloc; st[1] = nx; }
        const unsigned old = xb_add(&bar[XB_XSUB(x)], 1u);
        const unsigned gen = old / nloc;
        if (old + 1u == (gen + 1u) * nloc) {
            __builtin_amdgcn_fence(__ATOMIC_RELEASE, "agent");
            asm volatile("s_waitcnt vmcnt(0)" ::: "memory");
            const unsigned og = xb_add(&bar[XB_TOP], 1u);
            const unsigned tg = og / nx;
            if (og + 1u == (tg + 1u) * nx) xb_add(&bar[XB_TOPGEN], 1u);
            else XB_SPIN(xb_ld(&bar[XB_TOPGEN]) == tg, bar);
            __builtin_amdgcn_fence(__ATOMIC_ACQUIRE, "agent");
            xb_add(&bar[XB_XGEN(x)], 1u);
            asm volatile("s_waitcnt vmcnt(0)" ::: "memory");
        } else {
            XB_SPIN(xb_ld(&bar[XB_XGEN(x)]) == gen, bar);
            __builtin_amdgcn_fence(__ATOMIC_ACQUIRE, "agent");
            asm volatile("s_waitcnt vmcnt(0)" ::: "memory");
        }
    }
    __syncthreads();
}

enum { OP_NONE = 0, OP_PROLOGUE, OP_SWIGLU, OP_SCALED0, OP_SCALED1, OP_SCALED2, OP_RESID, OP_GATE, OP_ATT_SBDIL, OP_ATT_MLA, OP_ATT_CROSS, OP_FINAL };
DI int op_kind(int ph, int op) {
    if (ph == 0) return op == 0 ? OP_PROLOGUE : OP_NONE;
    if (ph == 49) return op == 0 ? OP_FINAL : OP_NONE;
    const int k = (ph - 1) % 24;
    if (k == 0) return op == 0 ? OP_SWIGLU : OP_NONE;
    if (k == 1 || k == 18 || k == 21 || k == 23) return op == 0 ? OP_RESID : OP_NONE;
    if (k == 19) return op == 0 ? OP_SCALED0 : OP_NONE;
    if (k == 20) return op == 0 ? OP_ATT_CROSS : OP_NONE;
    if (k == 22) return op == 0 ? OP_SWIGLU : OP_NONE;
    const int sub = (k - 2) & 3;
    if (sub == 0) return op == 0 ? OP_SCALED1 : OP_NONE;
    if (sub == 1) return op == 0 ? OP_SCALED2 : (op == 1 ? OP_SCALED0 : OP_ATT_SBDIL);
    if (sub == 2) return op == 0 ? OP_ATT_MLA : OP_NONE;
    return op == 0 ? OP_GATE : ((op == 1 && k == 5) ? OP_SCALED0 : OP_NONE);
}

__global__ void __launch_bounds__(512, 2) mega(Params p) {
    extern __shared__ __attribute__((aligned(16))) unsigned char lds_raw[];
    LAS unsigned char* lds = (LAS unsigned char*)lds_raw;
    LAS int* s_item = (LAS int*)(lds + LDS_CTL);
    const kptr_t ka = (kptr_t)__builtin_amdgcn_kernarg_segment_ptr();
    volatile LAS unsigned* xb_st = (volatile LAS unsigned*)(lds + LDS_CTL + 16);
    if (threadIdx.x < 2) xb_st[threadIdx.x] = 0u;
    __syncthreads();
    const int ph_lo = *(const __attribute__((address_space(4))) int*)(ka + 240), ph_hi = *(const __attribute__((address_space(4))) int*)(ka + 244);
#define WSP(T_, off) ((T_*)(wsb + (off)))
#define QUEUE_BEGIN(n) for (;;) { __syncthreads(); if (tid == 0) *s_item = atomicAdd(WSP(int, WS_CTR) + ph + 50 * rep_, 1); __syncthreads(); const int item = *s_item; if (item >= (n)) break;
#define QUEUE_END }

#pragma unroll 1
    for (int ph = ph_lo; ph < ph_hi; ++ph) {
#pragma unroll 1
        for (int op = 0; op < 3; ++op) {
            const int kind = op_kind(ph, op);
            if (kind == OP_NONE) break;
            kptr_t kb = ka; asm volatile("" : "+s"(kb));
            unsigned char* wsb = KWS;
            const int G = gridDim.x, bid = blockIdx.x;
            const int l = (ph - 1) / 24, k = (ph - 1) % 24, ch = (k - 2) >> 2;
            const size_t row0 = (size_t)ch * TC;
            bf16_t* wl = WSP(bf16_t, WS_W) + (size_t)l * W_LAYER;
            float* ssz = WSP(float, WS_SSZ);
            unsigned char* R1 = wsb + WS_R1;
#pragma unroll 1
            for (int rep_ = 0; rep_ < ((kind == OP_ATT_SBDIL || kind == OP_ATT_MLA || kind == OP_ATT_CROSS) ? MK_REP_ATT : ((kind == OP_SWIGLU) ? MK_REP_GEMM : 1)); ++rep_)
            switch (kind) {
            case OP_PROLOGUE: {
#ifndef SKIP_OP_PROLOGUE
                const int tid = ltid();
                const int gw = bid * 8 + (tid >> 6), nw = G * 8;
                for (size_t i = (size_t)bid * 512 + tid; i < (size_t)NSSZ * T; i += (size_t)G * 512) ssz[i] = 0.f;
                if (bid == 0) { if (tid < 256) WSP(int, WS_CTR)[tid] = 0; for (int i = tid; i < XCD_BAR_WORDS; i += 512) WSP(unsigned, WS_BAR)[i] = 0u; }
                rows_to_bf16(KIN(0), WSP(bf16_t, WS_HB), WSP(float, WS_SS0), T, gw, nw);
                rows_to_bf16(KIN(1), WSP(bf16_t, WS_MEMB), WSP(float, WS_SSM), NB * MEML, gw, nw);
                float* rope = WSP(float, WS_ROPE);
                for (int i = bid * 512 + tid; i < SEQ * 16; i += G * 512) {
                    const int pos = i >> 4, fi = i & 15;
                    const float freq = exp2f(-(float)fi * (13.287712379549449f / 16.0f));
                    const float ang = (float)pos * freq;
                    const double rev = (double)ang * 0.15915494309189535;
                    const float fr = (float)(rev - rint(rev));
                    rope[2 * i] = __builtin_amdgcn_cosf(fr); rope[2 * i + 1] = __builtin_amdgcn_sinf(fr);
                }
                float* biasT = WSP(float, WS_BIAS);
                for (int i = bid * 512 + tid; i < 3 * 8 * 132; i += G * 512) {
                    const int g = i / (8 * 132), h = (i / 132) % 8, s = i % 132;
                    float v = 0.f;
                    if (s <= 128) {
                        const int r = (g == 0) ? 1 : (g == 1 ? 4 : 16), dist = s * r;
                        int bucket;
                        if (dist < 16) bucket = dist;
                        else { const float dd = (float)dist; const int large = 16 + (int)(logf(dd / 16.0f) / logf(128.0f) * 16.0f); bucket = large < 31 ? large : 31; }
                        v = KIN(17)[bucket * 24 + g * 8 + h] * LOG2E;
                    }
                    biasT[i] = v;
                }
                int goff_ = 0;
#pragma unroll 1
                for (int wi = 0; wi < 28; ++wi) goff_ = convert_weight(lds, wdesc(kb, WSP(bf16_t, WS_W) + (size_t)(wi / 14) * W_LAYER, wi / 14, wi % 14), G, bid, goff_);
#endif
            } break;
            case OP_SWIGLU: {
#ifndef SKIP_OP_SWIGLU
                const bool second = (k == 22);
                const float* ss_in = second ? (ssz + (size_t)(l * 4 + 2) * T) : (l == 0 ? WSP(float, WS_SS0) : ssz + (size_t)3 * T);
                pg8::Gemm g{WSP(bf16_t, WS_HB), wl + (second ? WO_GU2 : WO_GU1), 1024, 1024, T, 5632, 1024}; pg8::StaticOrder S; S.init(T, 5632, G, bid);
                pg8::EpiSwiglu E{(bf16_t*)(R1 + R_ACT), FF, ss_in}; pg8::gemm_phase(lds, g, S, E);
#endif
            } break;
            case OP_SCALED0: {
#ifndef SKIP_OP_SCALED0
                pg8::Gemm g; pg8::StaticOrder S; pg8::EpiScaled<0> E; E.ss_cq = nullptr; E.ss_ckv = nullptr; E.rope = nullptr;
                if (k == 5) {
                    g = pg8::Gemm{WSP(bf16_t, WS_MEMB), wl + WO_XKV, 1024, 1024, 2048, 1024, 1024}; S.init(2048, 1024, G, (bid + G - 128) % G);
                    E.O = WSP(bf16_t, WS_KVX) + (size_t)l * 2048 * 1024; E.ldc = 1024; E.ss = WSP(float, WS_SSM); E.inv_dim = 1.0f / 1024.0f;
                } else if (k == 19) {
                    g = pg8::Gemm{WSP(bf16_t, WS_HB), wl + WO_XQ, 1024, 1024, T, 512, 1024}; S.init(T, 512, G, bid);
                    E.O = (bf16_t*)(R1 + R_QX); E.ldc = 512; E.ss = ssz + (size_t)(l * 4 + 1) * T; E.inv_dim = 1.0f / 1024.0f;
                } else {
                    g = pg8::Gemm{(bf16_t*)(R1 + R_P) + C_CKV, wl + WO_UKV, NINP, 256, TC, 1024, 256}; S.init(TC, 1024, G, (bid + G - 96) % G);
                    E.O = (bf16_t*)(R1 + R_KVM); E.ldc = 1024; E.ss = ssz + (size_t)(9 + l * 2) * T + row0; E.inv_dim = 1.0f / 128.0f;
                }
                pg8::gemm_phase(lds, g, S, E);
#endif
            } break;
            case OP_SCALED1: {
#ifndef SKIP_OP_SCALED1
                pg8::Gemm g{WSP(bf16_t, WS_HB) + row0 * 1024, wl + WO_IN, 1024, 1024, TC, NINP, 1024}; pg8::StaticOrder S; S.init(TC, NINP, G, bid);
                pg8::EpiScaled<1> E{(bf16_t*)(R1 + R_P), NINP, ssz + (size_t)(l * 4 + 0) * T + row0, 1.0f / 1024.0f, ssz + (size_t)(8 + l * 2) * T + row0, ssz + (size_t)(9 + l * 2) * T + row0, WSP(float, WS_ROPE)};
                pg8::gemm_phase(lds, g, S, E);
#endif
            } break;
            case OP_SCALED2: {
#ifndef SKIP_OP_SCALED2
                pg8::Gemm g{(bf16_t*)(R1 + R_P) + C_CQ, wl + WO_UQ, NINP, 384, TC, 768, 384}; pg8::StaticOrder S; S.init(TC, 768, G, bid);
                pg8::EpiScaled<2> E{(bf16_t*)(R1 + R_QM), 768, ssz + (size_t)(8 + l * 2) * T + row0, 1.0f / 384.0f, nullptr, nullptr, WSP(float, WS_ROPE)};
                pg8::gemm_phase(lds, g, S, E);
#endif
            } break;
            case OP_RESID: {
#ifndef SKIP_OP_RESID
                const bool f1 = (k == 1), mo = (k == 18), xo = (k == 21);
                const size_t aoffb = mo ? R_MB : (xo ? R_OX : R_ACT);
                const size_t woff = f1 ? WO_D1 : (mo ? WO_MO : (xo ? WO_XO : WO_D2));
                const int kk = mo ? 1024 : (xo ? 512 : FF);
                const int ssi = l * 4 + (f1 ? 0 : (mo ? 1 : (xo ? 2 : 3)));
                float* const hout_ = KOUT;
                const float* const x_ = KIN(0);
                const float* const hin_ = (f1 && l == 0) ? x_ : (const float*)hout_;
                pg8::Gemm g{(bf16_t*)(R1 + aoffb), wl + woff, kk, kk, T, 1024, kk}; pg8::StaticOrder S; S.init(T, 1024, G, bid);
                pg8::EpiResid E{hin_, hout_, (l == 1 && k == 23) ? (bf16_t*)nullptr : WSP(bf16_t, WS_HB), ssz + (size_t)ssi * T, (mo || xo) ? 1.0f : 0.5f};
                pg8::gemm_phase(lds, g, S, E);
#endif
            } break;
            case OP_GATE: {
#ifndef SKIP_OP_GATE
                pg8::Gemm g{(bf16_t*)(R1 + R_OA), wl + WO_BA, 512, 512, 3 * TC, 3072, 512}; pg8::StaticOrder S; S.init(2 * TC, 1024, G, bid); S.passes(3, TC / 128, 4);
                pg8::EpiGate E{(bf16_t*)(R1 + R_P) + C_GATE, NINP, KIN(8) + (size_t)(l * 3) * 1024, (float*)(R1 + R_M32), (bf16_t*)(R1 + R_MB) + row0 * 1024};
                pg8::gemm_phase<pg8::EpiGate, true>(lds, g, S, E);
#endif
            } break;
            case OP_ATT_SBDIL: {
#ifndef SKIP_OP_ATT_SBDIL
                const int tid = ltid();
                bf16_t* P = (bf16_t*)(R1 + R_P);
                for (int item = bid; item < 768; item += G) {
                    {
                        const int j = item, g = j >> 8, bl = (j >> 7) & 1, h = (j >> 4) & 7, sub = j & 15;
                        const int r = (g == 0) ? 1 : (g == 1 ? 4 : 16), cls = sub % r, qt = sub / r;
                        const bf16_t* base = P + C_DIL + g * 1536 + h * 64;
                        AttnArgs a; a.Q = base; a.ldq = NINP; a.K = base + 512; a.ldk = NINP; a.K2 = nullptr; a.ldk2 = 0;
                        a.V = base + 1024; a.ldv = NINP; a.O = (bf16_t*)(R1 + R_OG) + (size_t)g * TC * 512 + h * 64; a.ldo = 512;
                        a.lse = (float*)(R1 + R_LSE) + (size_t)g * TC * 8 + h; a.ldl = 8;
                        a.q0 = qt * 256; a.tstride = r; a.toff = bl * SEQ + cls; a.nk = 0; a.c2 = 0.125f * LOG2E; a.biasg = WSP(float, WS_BIAS) + (g * 8 + h) * 132;
                        attn_dil_unit(lds, a);
                    }
                }
#endif
            } break;
            case OP_ATT_MLA: {
#ifndef SKIP_OP_ATT_MLA
                const int tid = ltid();
                QUEUE_BEGIN(512 + 256)
                    if (item >= 256 && item < 512) {
                        bf16_t* P = (bf16_t*)(R1 + R_P);
                        const int qt = 15 - ((item - 256) >> 4), bl = (item >> 3) & 1, h = item & 7;
                        AttnArgs a; a.Q = P + C_SBQ + h * 64; a.ldq = NINP; a.K = P + C_SBK + h * 64; a.ldk = NINP; a.K2 = nullptr; a.ldk2 = 0;
                        a.V = P + C_SBV + h * 64; a.ldv = NINP; a.O = (bf16_t*)(R1 + R_OA) + h * 64; a.ldo = 512; a.lse = nullptr; a.ldl = 0;
                        a.q0 = qt * 256; a.tstride = 1; a.toff = bl * SEQ; a.nk = 0; a.c2 = 0.125f * LOG2E; a.biasg = nullptr;
                        attn_unit<2>(lds, a);
                    } else if (item < 256) {
                        const int qt = 15 - (item >> 4), bl = (item >> 3) & 1, h = item & 7;
                        bf16_t* kvm = (bf16_t*)(R1 + R_KVM);
                        AttnArgs a; a.Q = (bf16_t*)(R1 + R_QM) + h * 96; a.ldq = 768; a.K = kvm + h * 128; a.ldk = 1024; a.K2 = (bf16_t*)(R1 + R_P) + C_KR; a.ldk2 = NINP;
                        a.V = kvm + h * 128 + 64; a.ldv = 1024; a.O = (bf16_t*)(R1 + R_OA) + (size_t)TC * 512 + h * 64; a.ldo = 512; a.lse = nullptr; a.ldl = 0;
                        a.q0 = qt * 256; a.tstride = 1; a.toff = bl * SEQ; a.nk = 0; a.c2 = 0.10206207261596577f * LOG2E; a.biasg = nullptr;
                        attn_unit<1>(lds, a);
                    } else {
                        const int t0 = (item - 512) * 32;
                        bf16_t* oc = (bf16_t*)(R1 + R_OA) + (size_t)2 * TC * 512;
                        const bf16_t* og = (const bf16_t*)(R1 + R_OG);
                        const float* lse = (const float*)(R1 + R_LSE);
#pragma unroll
                        for (int ps = 0; ps < 4; ++ps) {
                            const int tok = t0 + ps * 8 + (tid >> 6), c8 = (tid & 63) * 8, h = c8 >> 6;
                            const float l0 = lse[(size_t)tok * 8 + h], l1 = lse[(size_t)(TC + tok) * 8 + h], l2 = lse[(size_t)(2 * TC + tok) * 8 + h];
                            const float mx = fmaxf(l0, fmaxf(l1, l2));
                            float w0 = ex2(l0 - mx), w1 = ex2(l1 - mx), w2 = ex2(l2 - mx);
                            const float is = 1.0f / (w0 + w1 + w2); w0 *= is; w1 *= is; w2 *= is;
                            const u32x4 a0 = *(const u32x4*)(og + (size_t)tok * 512 + c8), a1 = *(const u32x4*)(og + (size_t)(TC + tok) * 512 + c8), a2 = *(const u32x4*)(og + (size_t)(2 * TC + tok) * 512 + c8);
                            u32x4 w;
                            w.x = pk2(w0 * bflo(a0.x) + w1 * bflo(a1.x) + w2 * bflo(a2.x), w0 * bfhi(a0.x) + w1 * bfhi(a1.x) + w2 * bfhi(a2.x));
                            w.y = pk2(w0 * bflo(a0.y) + w1 * bflo(a1.y) + w2 * bflo(a2.y), w0 * bfhi(a0.y) + w1 * bfhi(a1.y) + w2 * bfhi(a2.y));
                            w.z = pk2(w0 * bflo(a0.z) + w1 * bflo(a1.z) + w2 * bflo(a2.z), w0 * bfhi(a0.z) + w1 * bfhi(a1.z) + w2 * bfhi(a2.z));
                            w.w = pk2(w0 * bflo(a0.w) + w1 * bflo(a1.w) + w2 * bflo(a2.w), w0 * bfhi(a0.w) + w1 * bfhi(a1.w) + w2 * bfhi(a2.w));
                            *(u32x4*)(oc + (size_t)tok * 512 + c8) = w;
                        }
                    }
                QUEUE_END
#endif
            } break;
            case OP_ATT_CROSS: {
#ifndef SKIP_OP_ATT_CROSS
                const int tid = ltid();
                const bf16_t* kvxl = WSP(bf16_t, WS_KVX) + (size_t)l * 2048 * 1024;
                for (int item = bid; item < 512; item += G) {
                    const int b = item >> 6, h = (item >> 4) & 3, qt = item & 15;
                    AttnArgs a; a.Q = (bf16_t*)(R1 + R_QX) + (size_t)b * SEQ * 512 + h * 128; a.ldq = 512;
                    a.K = kvxl + (size_t)b * MEML * 1024 + h * 128; a.ldk = 1024; a.K2 = nullptr; a.ldk2 = 0;
                    a.V = kvxl + (size_t)b * MEML * 1024 + 512 + h * 128; a.ldv = 1024;
                    a.O = (bf16_t*)(R1 + R_OX) + (size_t)b * SEQ * 512 + h * 128; a.ldo = 512; a.lse = nullptr; a.ldl = 0;
                    a.q0 = qt * 256; a.tstride = 1; a.toff = 0; a.nk = MEML; a.c2 = 0.08838834764831845f * LOG2E; a.biasg = nullptr;
                    attn_unit<0>(lds, a);
                }
#endif
            } break;
            default: {
                const int tid = ltid();
                const float* ssf = ssz + (size_t)7 * T;
                const float* gf = KIN(27);
                float* hres = KOUT;
                const int lane = tid & 63;
                for (int r = bid * 8 + (tid >> 6); r < T; r += G * 8) {
                    const float rs = __builtin_amdgcn_rsqf(ssf[r] * (1.0f / 1024.0f) + EPS);
#pragma unroll
                    for (int i = 0; i < 4; ++i) {
                        const size_t off = (size_t)r * 1024 + i * 256 + lane * 4;
                        f32x4 v = *(const f32x4*)(hres + off); const f32x4 gg = *(const f32x4*)(gf + i * 256 + lane * 4);
                        v = v * rs * gg;
                        *(f32x4*)(hres + off) = v;
                    }
                }
            } break;
            }
        }
        if (ph + 1 < ph_hi) {
            kptr_t kb = ka; asm volatile("" : "+s"(kb));
            unsigned* bar = (unsigned*)(KWS + WS_BAR);
            if (ph == 0) {
                cg::this_grid().sync();
                if (threadIdx.x == 0) (void)xb_add(&bar[XB_XCNT(xb_xcc_id())], 1u);
            } else {
                for (int rs_ = 0; rs_ < MK_REP_SYNC; ++rs_) xcd_barrier(bar, xb_st);
            }
        }
    }
}

constexpr int N_PHASES = 50;

extern "C" void kernel_launch(void* const* d_in, const int* in_sizes, int n_in, void* d_out, int out_size, void* d_ws, size_t ws_size, hipStream_t stream) {
    static int grid = 0;
    if (grid == 0) {
        if (n_in != 28 || out_size != T * DM || ws_size < WS_END) { fprintf(stderr, "kernel_launch: unexpected shapes (n_in %d out %d ws %zu need %zu)\n", n_in, out_size, ws_size, (size_t)WS_END); grid = -1; return; }
        int dev = 0, cus = 0, per_cu = 0;
        hipGetDevice(&dev);
        hipDeviceGetAttribute(&cus, hipDeviceAttributeMultiprocessorCount, dev);
        if (hipFuncSetAttribute((const void*)mega, hipFuncAttributeMaxDynamicSharedMemorySize, LDS_BYTES) != hipSuccess) { fprintf(stderr, "kernel_launch: hipFuncSetAttribute failed\n"); grid = -1; return; }
        if (hipOccupancyMaxActiveBlocksPerMultiprocessor(&per_cu, (const void*)mega, 512, LDS_BYTES) != hipSuccess || per_cu < 1) { fprintf(stderr, "kernel_launch: occupancy query says %d\n", per_cu); per_cu = 1; }
        (void)hipGetLastError();
        grid = cus * 1;
        fprintf(stderr, "kernel_launch: grid %d (cus %d, per_cu %d)\n", grid, cus, per_cu);
    }
    if (grid < 0) return;
    Params p{};
    for (int i = 0; i < 28; ++i) p.in[i] = (const float*)d_in[i];
    p.out = (float*)d_out; p.ws = (unsigned char*)d_ws;
#if MK_PER_PHASE
    for (int k = MK_MINPH; k < MK_MAXPH; ++k) { p.ph_lo = k; p.ph_hi = k + 1; hipLaunchKernelGGL(mega, dim3(grid), dim3(512), LDS_BYTES, stream, p); }
#else
    p.ph_lo = 0; p.ph_hi = MK_MAXPH;
    void* args[] = {&p};
    hipError_t e = hipLaunchCooperativeKernel((const void*)mega, dim3(grid), dim3(512), args, LDS_BYTES, stream);
    if (e != hipSuccess) fprintf(stderr, "kernel_launch: cooperative launch failed: %s (grid %d)\n", hipGetErrorString(e), grid);
#endif
}
```
